# Optimizing an MI355X kernel written in HIP

```python
import jax
import jax.numpy as jnp
from jax import lax
import numpy as np

D_MODEL = 1024
BATCH = 8
SEQ = 4096
DEPTH = 4

CTX_LEN = 256
GRID_W = 64
N_MIXERS = 3
Q_BLOCK = 128
ROPE_THETA = 10000.0
NORM_EPS = 1e-6
NEG_INF = -1e30

A_HEADS = 8
A_KV_HEADS = 2
A_HEAD_DIM = D_MODEL // A_HEADS
B_HEADS = 16
B_KV_HEADS = 4
B_HEAD_DIM = D_MODEL // B_HEADS
WINDOW = 128
C_HEAD_DIM = 64
C_HEADS = D_MODEL // C_HEAD_DIM
C_DECAY_LORA = 64
C_AAA_LORA = 64
C_GATE_LORA = 128
C_GN_EPS = C_HEAD_DIM * 1e-5
N_EXPERTS = 16
EXPERT_FF = 2 * D_MODEL
CAPACITY_FACTOR = 2

N_A = (DEPTH + 2) // N_MIXERS
N_B = (DEPTH + 1) // N_MIXERS
N_C = DEPTH // N_MIXERS

kernel_name = 'hybrid_diffusion_trunk_gqa_swa_rwkv7_ecmoe'


def rms_norm(x):
    x32 = x.astype(jnp.float32)
    return (x32 * lax.rsqrt(jnp.mean(x32 * x32, axis=-1, keepdims=True) + NORM_EPS)).astype(x.dtype)


def modulate(x, shift, scale):
    return rms_norm(x) * (1 + scale) + shift


def grid_positions(n_tokens):
    n_rows = n_tokens // GRID_W
    rows = jnp.repeat(jnp.arange(n_rows, dtype=jnp.int32), GRID_W)
    cols = jnp.tile(jnp.arange(GRID_W, dtype=jnp.int32), n_rows)
    return rows, cols


def axial_rope_tables(rows, cols, head_dim):
    n_freq = head_dim // 4
    inv_freq = ROPE_THETA ** (-jnp.arange(n_freq, dtype=jnp.float32) / n_freq)
    ang = jnp.concatenate([rows.astype(jnp.float32)[:, None] * inv_freq,
                           cols.astype(jnp.float32)[:, None] * inv_freq], axis=-1)
    return jnp.cos(ang), jnp.sin(ang)


def apply_rope(x, cos, sin):
    bshape = (1, cos.shape[0]) + (1,) * (x.ndim - 3) + (cos.shape[1],)
    cos, sin = cos.reshape(bshape), sin.reshape(bshape)
    x1, x2 = jnp.split(x.astype(jnp.float32), 2, axis=-1)
    return jnp.concatenate([x1 * cos - x2 * sin, x1 * sin + x2 * cos], axis=-1).astype(x.dtype)


def project_qkv(h, w_qkv, n_heads, n_kv, head_dim):
    b, t, _ = h.shape
    q, k, v = jnp.split(h @ w_qkv, [n_heads * head_dim, (n_heads + n_kv) * head_dim], axis=-1)
    return (q.reshape(b, t, n_kv, n_heads // n_kv, head_dim),
            k.reshape(b, t, n_kv, head_dim), v.reshape(b, t, n_kv, head_dim))


def dense_attend(q, k, v, scale):
    s = jnp.einsum('bqhgd,bkhd->bhgqk', q, k).astype(jnp.float32) * scale
    p = jax.nn.softmax(s, axis=-1).astype(v.dtype)
    return jnp.einsum('bhgqk,bkhd->bqhgd', p, v)


def global_gqa(hc, hl, w_qkv, w_o, q_gain, k_gain, cos, sin, last):
    b, n_lat, _ = hl.shape
    scale = A_HEAD_DIM ** -0.5
    qc, kc, vc = project_qkv(hc, w_qkv, A_HEADS, A_KV_HEADS, A_HEAD_DIM)
    ql, kl, vl = project_qkv(hl, w_qkv, A_HEADS, A_KV_HEADS, A_HEAD_DIM)
    qc, ql = rms_norm(qc) * q_gain, rms_norm(ql) * q_gain
    kc, kl = rms_norm(kc) * k_gain, rms_norm(kl) * k_gain
    ql, kl = apply_rope(ql, cos, sin), apply_rope(kl, cos, sin)
    k_all = jnp.concatenate([kl, kc], axis=1)
    v_all = jnp.concatenate([vl, vc], axis=1)
    n_blk = n_lat // Q_BLOCK
    q_blocks = jnp.moveaxis(ql.reshape(b, n_blk, Q_BLOCK, *ql.shape[2:]), 1, 0)
    o = lax.map(lambda q: dense_attend(q, k_all, v_all, scale), q_blocks)
    yl = jnp.moveaxis(o, 0, 1).reshape(b, n_lat, D_MODEL) @ w_o
    if last:
        return None, yl
    yc = dense_attend(qc, kc, vc, scale).reshape(hc.shape) @ w_o
    return yc, yl


def sink_softmax(scores, sink):
    col = jnp.broadcast_to(sink.astype(jnp.float32)[:, :, None, None], scores[0].shape[:-1] + (1,))
    p = jax.nn.softmax(jnp.concatenate(scores + [col], axis=-1), axis=-1)
    return p[..., :-1]


def window_gqa_sink(hc, hl, w_qkv, w_o, sink, cos, sin, last):
    b, n_lat, _ = hl.shape
    scale = B_HEAD_DIM ** -0.5
    sink = sink.reshape(B_KV_HEADS, B_HEADS // B_KV_HEADS)
    qc, kc, vc = project_qkv(hc, w_qkv, B_HEADS, B_KV_HEADS, B_HEAD_DIM)
    ql, kl, vl = project_qkv(hl, w_qkv, B_HEADS, B_KV_HEADS, B_HEAD_DIM)
    ql, kl = apply_rope(ql, cos, sin), apply_rope(kl, cos, sin)
    pad = ((0, 0), (Q_BLOCK, Q_BLOCK), (0, 0), (0, 0))
    kp, vp = jnp.pad(kl, pad), jnp.pad(vl, pad)
    n_blk = n_lat // Q_BLOCK
    q_blocks = jnp.moveaxis(ql.reshape(b, n_blk, Q_BLOCK, *ql.shape[2:]), 1, 0)

    def block(args):
        blk, q = args
        start = blk * Q_BLOCK
        kw = lax.dynamic_slice_in_dim(kp, start, 3 * Q_BLOCK, axis=1)
        vw = lax.dynamic_slice_in_dim(vp, start, 3 * Q_BLOCK, axis=1)
        q_pos = start + jnp.arange(Q_BLOCK)
        k_pos = start - Q_BLOCK + jnp.arange(3 * Q_BLOCK)
        band = ((jnp.abs(k_pos[None, :] - q_pos[:, None]) <= WINDOW)
                & (k_pos >= 0)[None, :] & (k_pos < n_lat)[None, :])
        s_win = jnp.where(band, jnp.einsum('bqhgd,bkhd->bhgqk', q, kw).astype(jnp.float32) * scale, NEG_INF)
        s_ctx = jnp.einsum('bqhgd,bkhd->bhgqk', q, kc).astype(jnp.float32) * scale
        p = sink_softmax([s_win, s_ctx], sink).astype(vw.dtype)
        return (jnp.einsum('bhgqk,bkhd->bqhgd', p[..., :3 * Q_BLOCK], vw)
                + jnp.einsum('bhgqk,bkhd->bqhgd', p[..., 3 * Q_BLOCK:], vc))

    o = lax.map(block, (jnp.arange(n_blk), q_blocks))
    yl = jnp.moveaxis(o, 0, 1).reshape(b, n_lat, D_MODEL) @ w_o
    if last:
        return None, yl
    s = jnp.einsum('bqhgd,bkhd->bhgqk', qc, kc).astype(jnp.float32) * scale
    p = sink_softmax([s], sink).astype(vc.dtype)
    yc = jnp.einsum('bhgqk,bkhd->bqhgd', p, vc).reshape(hc.shape) @ w_o
    return yc, yl


def centred_shift(x):
    xp = jnp.pad(x, ((0, 0), (1, 1), (0, 0)))
    return 0.5 * (xp[:, :-2] + xp[:, 2:]) - x


def rwkv_features(h, mu, w_rkv, w0, w1, w2, a0, a1, a2, g1, g2, k_k, k_a):
    f32 = jnp.float32
    heads = lambda t: t.reshape(*t.shape[:-1], C_HEADS, C_HEAD_DIM)
    xx = centred_shift(h)
    xr, xw, xk, xv, xa, xg = h[None] + xx[None] * mu[:, None, None, :]
    r, k, v = jnp.einsum('jbtd,jde->jbte', jnp.stack([xr, xk, xv]), w_rkv)
    w_lora = jnp.einsum('jbtr,jrd->jbtd', jnp.tanh(jnp.einsum('btd,jdr->jbtr', xw, w1)), w2)
    log_w = -jax.nn.softplus(-(w0[:, None, None, :] + w_lora).astype(f32)) - 0.5
    decay = jnp.exp(-jnp.exp(log_w))
    a = jax.nn.sigmoid((a0[:, None, None, :]
                        + jnp.einsum('jbtr,jrd->jbtd', jnp.einsum('btd,jdr->jbtr', xa, a1), a2)).astype(f32))
    g = jax.nn.sigmoid(xg @ g1) @ g2
    kk = heads((k * k_k).astype(f32))
    kk = kk * lax.rsqrt(jnp.maximum(jnp.sum(kk * kk, axis=-1, keepdims=True), 1e-24))
    k_dir = heads(k.astype(f32)[None] * (1 + (a - 1) * k_a.astype(f32)))
    return heads(r.astype(f32)), heads(decay), k_dir, heads(v.astype(f32)), -kk, kk[None] * heads(a), g


def wkv_scan(r, w, k, v, a, b, state0, reverse):
    def step(s, inp):
        r_t, w_t, k_t, v_t, a_t, b_t = inp
        sa = jnp.einsum('bhvk,bhk->bhv', s, a_t)
        s = s * w_t[:, :, None, :] + sa[..., None] * b_t[:, :, None, :] + v_t[..., None] * k_t[:, :, None, :]
        return s, jnp.einsum('bhvk,bhk->bhv', s, r_t)
    xs = tuple(jnp.swapaxes(t, 0, 1) for t in (r, w, k, v, a, b))
    s_final, o = lax.scan(step, state0, xs, reverse=reverse)
    return s_final, jnp.swapaxes(o, 0, 1)


def rwkv7_bidir(hc, hl, mu, w_rkv, w_o, w0, w1, w2, a0, a1, a2, g1, g2, k_k, k_a, r_k, ln_w, ln_b, last):
    fc = rwkv_features(hc, mu, w_rkv, w0, w1, w2, a0, a1, a2, g1, g2, k_k, k_a)
    fl = rwkv_features(hl, mu, w_rkv, w0, w1, w2, a0, a1, a2, g1, g2, k_k, k_a)
    zero = jnp.zeros((hl.shape[0], C_HEADS, C_HEAD_DIM, C_HEAD_DIM), jnp.float32)

    def scan_dir(f, d, state0):
        r, w, k, v, a_vec, b_vec, _ = f
        return wkv_scan(r, w[d], k[d], v, a_vec, b_vec[d], state0, reverse=(d == 1))

    s_fc, o_fc = scan_dir(fc, 0, zero)
    s_bc, o_bc = scan_dir(fc, 1, zero)
    _, o_fl = scan_dir(fl, 0, s_fc)
    _, o_bl = scan_dir(fl, 1, s_bc)

    def readout(f, o_f, o_b, dtype):
        r, _, k, v, _, _, g = f
        o = o_f + o_b
        o = o - jnp.mean(o, axis=-1, keepdims=True)
        o = o * lax.rsqrt(jnp.mean(o * o, axis=-1, keepdims=True) + C_GN_EPS)
        o = o.reshape(*o.shape[:2], D_MODEL) * ln_w + ln_b
        bonus = jnp.sum(jnp.sum(r[None] * k * r_k[:, None, None], axis=-1, keepdims=True), axis=0) * v
        return ((o + bonus.reshape(o.shape)) * g).astype(dtype) @ w_o

    yl = readout(fl, o_fl, o_bl, hl.dtype)
    if last:
        return None, yl
    return readout(fc, o_fc, o_bc, hc.dtype), yl


def expert_choice_ffn(h, router_w, w1, w3, w2):
    b, t, d = h.shape
    cap = CAPACITY_FACTOR * t // N_EXPERTS
    aff = jax.nn.softmax((h @ router_w).astype(jnp.float32), axis=-1)
    gate, idx = lax.top_k(jnp.swapaxes(aff, 1, 2), cap)
    xs = jax.vmap(lambda hb, ib: hb[ib])(h, idx)
    hid = jax.nn.silu(jnp.einsum('becd,edf->becf', xs, w1)) * jnp.einsum('becd,edf->becf', xs, w3)
    out = jnp.einsum('becf,efd->becd', hid, w2) * gate[..., None].astype(h.dtype)
    return jax.vmap(lambda ib, ob: jnp.zeros((t, d), h.dtype).at[ib.reshape(-1)].add(ob.reshape(-1, d)))(idx, out)


def setup_inputs(seed: int = 0) -> dict:
    key = jax.random.key(seed)
    ks = iter(jax.random.split(key, 48))
    f32 = jnp.float32
    D = D_MODEL

    def nrm(shape, scale):
        return jax.random.normal(next(ks), shape, f32) * scale

    qkv_a = (A_HEADS + 2 * A_KV_HEADS) * A_HEAD_DIM
    qkv_b = (B_HEADS + 2 * B_KV_HEADS) * B_HEAD_DIM
    return {
        'x': nrm((BATCH, SEQ, D), 1.0),
        'c': nrm((BATCH, D), 1.0),
        'ctx': nrm((BATCH, CTX_LEN, D), 1.0),
        'c_ctx': nrm((D,), 1.0),
        'mod_w': nrm((DEPTH, D, 6 * D), 0.5 * D ** -0.5),
        'mod_b': nrm((DEPTH, 6 * D), 0.02),
        'a_w_qkv': nrm((N_A, D, qkv_a), D ** -0.5),
        'a_w_o': nrm((N_A, D, D), D ** -0.5),
        'a_q_norm': 1.0 + nrm((N_A, A_HEAD_DIM), 0.02),
        'a_k_norm': 1.0 + nrm((N_A, A_HEAD_DIM), 0.02),
        'b_w_qkv': nrm((N_B, D, qkv_b), D ** -0.5),
        'b_w_o': nrm((N_B, D, D), D ** -0.5),
        'b_sink': nrm((N_B, B_HEADS), 0.5),
        'c_mu': jax.random.uniform(next(ks), (N_C, 6, D), f32),
        'c_w_rkv': nrm((N_C, 3, D, D), D ** -0.5),
        'c_w_o': nrm((N_C, D, D), D ** -0.5),
        'c_w0': jax.random.uniform(next(ks), (N_C, 2, D), f32, minval=-6.0, maxval=0.0),
        'c_w1': nrm((N_C, 2, D, C_DECAY_LORA), 0.1 * D ** -0.5),
        'c_w2': nrm((N_C, 2, C_DECAY_LORA, D), 0.1 * C_DECAY_LORA ** -0.5),
        'c_a0': nrm((N_C, 2, D), 0.1),
        'c_a1': nrm((N_C, 2, D, C_AAA_LORA), 0.1 * D ** -0.5),
        'c_a2': nrm((N_C, 2, C_AAA_LORA, D), 0.1 * C_AAA_LORA ** -0.5),
        'c_g1': nrm((N_C, D, C_GATE_LORA), D ** -0.5),
        'c_g2': nrm((N_C, C_GATE_LORA, D), C_GATE_LORA ** -0.5),
        'c_k_k': 0.85 + nrm((N_C, D), 0.02),
        'c_k_a': 1.0 + nrm((N_C, D), 0.02),
        'c_r_k': nrm((N_C, 2, C_HEADS, C_HEAD_DIM), 0.1),
        'c_ln_w': 1.0 + nrm((N_C, D), 0.02),
        'c_ln_b': nrm((N_C, D), 0.02),
        'router_w': nrm((DEPTH, D, N_EXPERTS), D ** -0.5),
        'ffn_w1': nrm((DEPTH, N_EXPERTS, D, EXPERT_FF), D ** -0.5),
        'ffn_w3': nrm((DEPTH, N_EXPERTS, D, EXPERT_FF), D ** -0.5),
        'ffn_w2': nrm((DEPTH, N_EXPERTS, EXPERT_FF, D), EXPERT_FF ** -0.5),
        'final_norm': 1.0 + nrm((D,), 0.02),
    }


def reference(x, c, ctx, c_ctx, mod_w, mod_b, a_w_qkv, a_w_o, a_q_norm, a_k_norm, b_w_qkv, b_w_o, b_sink,
              c_mu, c_w_rkv, c_w_o, c_w0, c_w1, c_w2, c_a0, c_a1, c_a2, c_g1, c_g2, c_k_k, c_k_a, c_r_k,
              c_ln_w, c_ln_b, router_w, ffn_w1, ffn_w3, ffn_w2, final_norm):
    n_lat = x.shape[1]
    rows, cols = grid_positions(n_lat)
    cos_a, sin_a = axial_rope_tables(rows, cols, A_HEAD_DIM)
    cos_b, sin_b = axial_rope_tables(rows, cols, B_HEAD_DIM)
    cond_l = jax.nn.silu(c)
    cond_c = jax.nn.silu(c_ctx)
    xl, xc = x, ctx
    for i in range(DEPTH):
        last = i == DEPTH - 1
        kind, j = i % N_MIXERS, i // N_MIXERS
        mod_l = (cond_l @ mod_w[i] + mod_b[i]).reshape(-1, 6, 1, D_MODEL)
        mod_c = (cond_c @ mod_w[i] + mod_b[i]).reshape(6, D_MODEL)
        hl = modulate(xl, mod_l[:, 0], mod_l[:, 1])
        hc = modulate(xc, mod_c[0], mod_c[1])
        if kind == 0:
            yc, yl = global_gqa(hc, hl, a_w_qkv[j], a_w_o[j], a_q_norm[j], a_k_norm[j], cos_a, sin_a, last)
        elif kind == 1:
            yc, yl = window_gqa_sink(hc, hl, b_w_qkv[j], b_w_o[j], b_sink[j], cos_b, sin_b, last)
        else:
            yc, yl = rwkv7_bidir(hc, hl, c_mu[j], c_w_rkv[j], c_w_o[j], c_w0[j], c_w1[j], c_w2[j],
                                 c_a0[j], c_a1[j], c_a2[j], c_g1[j], c_g2[j], c_k_k[j], c_k_a[j],
                                 c_r_k[j], c_ln_w[j], c_ln_b[j], last)
        xl = xl + mod_l[:, 2] * yl
        hl = modulate(xl, mod_l[:, 3], mod_l[:, 4])
        xl = xl + mod_l[:, 5] * expert_choice_ffn(hl, router_w[i], ffn_w1[i], ffn_w3[i], ffn_w2[i])
        if not last:
            xc = xc + mod_c[2] * yc
            hc = modulate(xc, mod_c[3], mod_c[4])
            xc = xc + mod_c[5] * expert_choice_ffn(hc, router_w[i], ffn_w1[i], ffn_w3[i], ffn_w2[i])
    return rms_norm(xl) * final_norm
```

```cpp
#include <hip/hip_runtime.h>
#include <stdint.h>
#include <stdio.h>

#ifndef MK_PER_PHASE
#define MK_PER_PHASE 0
#endif

#define DEVI __device__ __forceinline__
typedef unsigned short bf16_t;
typedef short bf16x8 __attribute__((ext_vector_type(8)));
typedef short s16x4 __attribute__((ext_vector_type(4)));
typedef float f32x4 __attribute__((ext_vector_type(4)));
typedef float f32x16 __attribute__((ext_vector_type(16)));
typedef unsigned u32x4 __attribute__((ext_vector_type(4)));
typedef unsigned u32x2 __attribute__((ext_vector_type(2)));
typedef int i32x4 __attribute__((ext_vector_type(4)));
typedef int i32x8 __attribute__((ext_vector_type(8)));

extern __shared__ __attribute__((aligned(16))) unsigned char shm[];
constexpr int D = 1024, NB = 8, T = 4096, CL = 256, DEPTH = 4;
constexpr int RL = NB * T, RC = NB * CL, R = RL + RC;
constexpr int KVLEN = T + CL;
constexpr int NE = 16, FF = 2048, CAPL = 512, CAPC = 32, EROWS = NB * (CAPL + CAPC), PAIRS = NE * EROWS;
constexpr int NTHREADS = 512, NWAVES = 8;
constexpr int LDS_BYTES = 144 * 1024;

constexpr size_t al256(size_t x) { return (x + 255) / 256 * 256; }
constexpr size_t WS_BAR = 0;
constexpr size_t WS_MODV = 65536;
constexpr size_t WS_ROPE = WS_MODV + al256((size_t)DEPTH * 9 * 6 * D * 4);
constexpr size_t WS_WQKV = WS_ROPE + 32768;
constexpr size_t WS_WO = WS_WQKV + (size_t)3 * 1536 * 1024 * 2;
constexpr size_t WS_WRKV = WS_WO + (size_t)4 * 1024 * 1024 * 2;
constexpr size_t WS_WL1 = WS_WRKV + (size_t)3 * 1024 * 1024 * 2;
constexpr size_t WS_WL2 = WS_WL1 + (size_t)3 * 256 * 1024 * 2;
constexpr size_t WS_F1 = WS_WL2 + (size_t)(4096 * 256 + 1024 * 128) * 2;
constexpr size_t WS_F2 = WS_F1 + (size_t)NE * 4096 * 1024 * 2;
constexpr size_t WS_X = WS_F2 + (size_t)NE * 1024 * 2048 * 2;
constexpr size_t WS_H = WS_X + (size_t)R * D * 4;
constexpr size_t WS_YEXP = WS_H + (size_t)R * D * 2;
constexpr size_t WS_AFF = WS_YEXP + (size_t)PAIRS * D * 2;
constexpr size_t WS_SLOT = WS_AFF + (size_t)R * 16 * 4;
constexpr size_t WS_IDX = WS_SLOT + (size_t)R * 16 * 4;
constexpr size_t WS_GATE = WS_IDX + al256((size_t)PAIRS * 4);
constexpr size_t WS_U = WS_GATE + al256((size_t)PAIRS * 4);
constexpr size_t WS_HID = WS_U;
constexpr size_t WS_XG = WS_HID + (size_t)PAIRS * FF * 2;
constexpr size_t WS_O = WS_U;
constexpr size_t WS_QKV = WS_O + (size_t)R * D * 2;
constexpr size_t WS_QB = WS_QKV + (size_t)R * 1536 * 4;
constexpr size_t WS_KB = WS_QB + (size_t)R * D * 2;
constexpr size_t WS_VT = WS_KB + (size_t)NB * KVLEN * 256 * 2;
constexpr size_t WS_ATT_END = WS_VT + (size_t)NB * KVLEN * 256 * 2;
constexpr size_t WS_U1 = WS_O + (size_t)R * D * 2;
constexpr size_t WS_RKVB = WS_U1 + (size_t)4 * R * D * 4;
constexpr size_t WS_L1 = WS_RKVB + (size_t)3 * R * D * 2;
constexpr size_t WS_GB = WS_L1 + (size_t)3 * R * 128 * 2;
constexpr size_t WS_OFB = WS_GB + (size_t)R * D * 2;
constexpr size_t WS_END = WS_OFB + (size_t)2 * R * D * 4;
static_assert(WS_ATT_END <= WS_END && WS_XG + (size_t)PAIRS * D * 2 <= WS_END, "union");
static_assert(WS_END <= 2000000000ull, "workspace budget");
static_assert(WS_HID + (size_t)PAIRS * FF * 2 <= WS_END, "union");

#define XB_TMO      128
#define XB_XCNT(j)  (256  + 64 * (j))
#define XB_XSUB(j)  (1280 + 64 * (j))
#define XB_XGEN(j)  (2304 + 64 * (j))
#define XB_TOP      3328
#define XB_TOPGEN   3392
#define XCD_BAR_WORDS 3456
#define XB_SPIN_CAP (1u << 22)
#define LAS __attribute__((address_space(3)))

__device__ __forceinline__ unsigned xb_ld(unsigned* p)              { return __hip_atomic_load(p, __ATOMIC_RELAXED, __HIP_MEMORY_SCOPE_AGENT); }
__device__ __forceinline__ unsigned xb_add(unsigned* p, unsigned v) { return __hip_atomic_fetch_add(p, v, __ATOMIC_RELAXED, __HIP_MEMORY_SCOPE_AGENT); }
__device__ __forceinline__ unsigned xb_xcc_id() { return (unsigned)__builtin_amdgcn_s_getreg((3 << 11) | 20) & 0xFu; }
#define XB_SPIN(cond, bar) do { unsigned _sp = 0; while (cond) { __builtin_amdgcn_s_sleep(1); \
    if ((++_sp & 255u) == 0u) { if (xb_ld(&(bar)[XB_TMO])) break; if (_sp > XB_SPIN_CAP) { atomicAdd(&(bar)[XB_TMO], 1u); break; } } } } while (0)

struct XcdBarrier { unsigned* bar; unsigned x; volatile LAS unsigned* st; };

__device__ __forceinline__ XcdBarrier xcd_barrier_post(unsigned* bar, volatile LAS unsigned* st) {
    XcdBarrier b; b.bar = bar; b.x = xb_xcc_id(); b.st = st;
    if (threadIdx.x == 0) (void)xb_add(&bar[XB_XCNT(b.x)], 1u);
    return b;
}
__device__ __forceinline__ void xcd_barrier_complete(unsigned* bar, unsigned x, unsigned& nloc, unsigned& nx) {
    const unsigned G = gridDim.x * gridDim.y * gridDim.z;
    unsigned sum, cnt, mine, sp = 0u;
    for (;;) {
        sum = 0u; cnt = 0u; mine = 0u;
#pragma unroll
        for (unsigned j = 0; j < 16; ++j) { const unsigned c = xb_ld(&bar[XB_XCNT(j)]); sum += c; cnt += (c > 0u) ? 1u : 0u; mine = (j == x) ? c : mine; }
        if (sum == G) break;
        __builtin_amdgcn_s_sleep(1);
        if ((++sp & 255u) == 0u) { if (xb_ld(&bar[XB_TMO])) break; if (sp > XB_SPIN_CAP) { atomicAdd(&bar[XB_TMO], 1u); break; } }
    }
    nloc = mine > 0u ? mine : 1u; nx = cnt > 0u ? cnt : 1u;
}
__device__ __forceinline__ void xcd_barrier(const XcdBarrier& b) {
    asm volatile("s_waitcnt vmcnt(0)" ::: "memory");
    __syncthreads();
    if (threadIdx.x == 0) {
        unsigned* bar = b.bar;
        __builtin_amdgcn_s_waitcnt(0);
        unsigned nloc = b.st[0], nx = b.st[1];
        if (nloc == 0u) { xcd_barrier_complete(bar, b.x, nloc, nx); b.st[0] = nloc; b.st[1] = nx; }
        const unsigned old = xb_add(&bar[XB_XSUB(b.x)], 1u);
        const unsigned gen = old / nloc;
        if (old + 1u == (gen + 1u) * nloc) {
            __builtin_amdgcn_fence(__ATOMIC_RELEASE, "agent");
            asm volatile("s_waitcnt vmcnt(0)" ::: "memory");
            const unsigned og = xb_add(&bar[XB_TOP], 1u);
            const unsigned tg = og / nx;
            if (og + 1u == (tg + 1u) * nx) xb_add(&bar[XB_TOPGEN], 1u);
            else XB_SPIN(xb_ld(&bar[XB_TOPGEN]) == tg, bar);
            __builtin_amdgcn_fence(__ATOMIC_ACQUIRE, "agent");
            xb_add(&bar[XB_XGEN(b.x)], 1u);
            asm volatile("s_waitcnt vmcnt(0)" ::: "memory");
        } else {
            XB_SPIN(xb_ld(&bar[XB_XGEN(b.x)]) == gen, bar);
            __builtin_amdgcn_fence(__ATOMIC_ACQUIRE, "agent");
            asm volatile("s_waitcnt vmcnt(0)" ::: "memory");
        }
    }
    __syncthreads();
}

DEVI int tid_opaque() { int t = threadIdx.x; asm volatile("" : "+v"(t)); return t; }
#define TIDX tid_opaque()
DEVI int bid_opaque() { int t = blockIdx.x; asm volatile("" : "+s"(t)); return t; }
#define BIDX bid_opaque()
typedef float f32x2 __attribute__((ext_vector_type(2)));
typedef __bf16 bf16x2_t __attribute__((ext_vector_type(2)));
DEVI float clamp448(float v) { return __builtin_amdgcn_fmed3f(v, -448.f, 448.f); }
DEVI unsigned cvt4_fp8(float a, float b, float c, float d) { int w = 0; w = __builtin_amdgcn_cvt_pk_fp8_f32(clamp448(a), clamp448(b), w, false); w = __builtin_amdgcn_cvt_pk_fp8_f32(clamp448(c), clamp448(d), w, true); return (unsigned)w; }
DEVI unsigned cvt_pk_bf16(float lo, float hi) { const f32x2 v = {lo, hi}; const bf16x2_t b = __builtin_convertvector(v, bf16x2_t); return __builtin_bit_cast(unsigned, b); }
DEVI unsigned cvt_pk_bf16_asm(float lo, float hi) { unsigned r; asm volatile("v_cvt_pk_bf16_f32 %0, %1, %2" : "=v"(r) : "v"(lo), "v"(hi)); return r; }
DEVI bf16_t f2bf(float x) { return (bf16_t)(cvt_pk_bf16(x, 0.f) & 0xffffu); }
DEVI float bf2f(bf16_t b) { return __uint_as_float(((unsigned)b) << 16); }
DEVI float bflo(unsigned w) { return __uint_as_float(w << 16); }
DEVI float bfhi(unsigned w) { return __uint_as_float(w & 0xffff0000u); }
DEVI int crow(int r, int hi) { return (r & 3) + 8 * (r >> 2) + 4 * hi; }
DEVI float sigmoidf_(float x) { return __builtin_amdgcn_rcpf(1.f + __builtin_amdgcn_exp2f(-1.4426950408889634f * x)); }
DEVI float siluf_(float x) { return x * __builtin_amdgcn_rcpf(1.f + __builtin_amdgcn_exp2f(-1.4426950408889634f * x)); }
DEVI float tanhf_(float x) { return 1.f - 2.f * __builtin_amdgcn_rcpf(1.f + __builtin_amdgcn_exp2f(2.8853900817779268f * x)); }
DEVI float wave_sum(float v) { v += __shfl_xor(v, 32); v += __shfl_xor(v, 16); v += __shfl_xor(v, 8); v += __shfl_xor(v, 4); v += __shfl_xor(v, 2); v += __shfl_xor(v, 1); return v; }
DEVI float wave_sum_dpp(float v) {
    v += __builtin_bit_cast(float, __builtin_amdgcn_update_dpp(0, __builtin_bit_cast(int, v), 0xB1, 0xF, 0xF, true));
    v += __builtin_bit_cast(float, __builtin_amdgcn_update_dpp(0, __builtin_bit_cast(int, v), 0x4E, 0xF, 0xF, true));
    v += __builtin_bit_cast(float, __builtin_amdgcn_update_dpp(0, __builtin_bit_cast(int, v), 0x141, 0xF, 0xF, true));
    v += __builtin_bit_cast(float, __builtin_amdgcn_update_dpp(0, __builtin_bit_cast(int, v), 0x140, 0xF, 0xF, true));
    { auto r = __builtin_amdgcn_permlane16_swap(__float_as_uint(v), __float_as_uint(v), false, false); v = __uint_as_float(r[0]) + __uint_as_float(r[1]); }
    { auto r = __builtin_amdgcn_permlane32_swap(__float_as_uint(v), __float_as_uint(v), false, false); v = __uint_as_float(r[0]) + __uint_as_float(r[1]); }
    return v; }
DEVI float sum32(float v) { v += __shfl_xor(v, 16); v += __shfl_xor(v, 8); v += __shfl_xor(v, 4); v += __shfl_xor(v, 2); v += __shfl_xor(v, 1); return v; }
DEVI float sum16(float v) { v += __shfl_xor(v, 8); v += __shfl_xor(v, 4); v += __shfl_xor(v, 2); v += __shfl_xor(v, 1); return v; }
DEVI int samp_of_row(int row) { return row < RL ? (row >> 12) : 8; }

struct P {
    const float *x, *c, *ctx, *c_ctx, *mod_w, *mod_b, *a_w_qkv, *a_w_o, *a_q_norm, *a_k_norm, *b_w_qkv, *b_w_o, *b_sink,
                *c_mu, *c_w_rkv, *c_w_o, *c_w0, *c_w1, *c_w2, *c_a0, *c_a1, *c_a2, *c_g1, *c_g2, *c_k_k, *c_k_a, *c_r_k, *c_ln_w, *c_ln_b,
                *router_w, *ffn_w1, *ffn_w3, *ffn_w2, *final_norm;
    float* out; unsigned char* ws; int ph_lo, ph_hi;
};
#define WSP(type, off) ((type*)(p.ws + (off)))

constexpr float F1_MUL = 32.f, F2_MUL = 64.f; constexpr int F1_SCALE = 0x7A7A7A7A, F2_SCALE = 0x79797979;
struct CvtJob { const float* src; int ld, K, N; bf16_t* dst; int lddst, blk, bstride, off, pmode; float mul8; };
DEVI void cvt_run(const CvtJob& j, int& cursor, float* lds) {
    const int tid = TIDX, tn = j.N / 64, nt = (j.K / 64) * tn, G = gridDim.x;
    int first = ((int)BIDX - (cursor % G) + G) % G;
    for (int t = first; t < nt; t += G) {
        const int k0 = (t / tn) * 64, n0 = (t % tn) * 64;
        { const int kk = tid >> 3, c8 = (tid & 7) * 8; const float* s = j.src + (size_t)(k0 + kk) * j.ld + n0 + c8;
          const f32x4 a = *(const f32x4*)s, b = *(const f32x4*)(s + 4); float* d = lds + kk * 65 + c8;
          d[0] = a[0]; d[1] = a[1]; d[2] = a[2]; d[3] = a[3]; d[4] = b[0]; d[5] = b[1]; d[6] = b[2]; d[7] = b[3]; }
        __syncthreads();
        { const int n = tid >> 3, k8 = (tid & 7) * 8; const float* s = lds + k8 * 65 + n;
          u32x4 w = {cvt_pk_bf16(s[0], s[65]), cvt_pk_bf16(s[130], s[195]), cvt_pk_bf16(s[260], s[325]), cvt_pk_bf16(s[390], s[455])};
          const int ng = n0 + n; int nd = (ng / j.blk) * j.bstride + (ng % j.blk) + j.off;
          if (j.pmode == 1) { const int Hh = ng >> 7, dd = ng & 127, rr = dd & 63; nd = 256 * (Hh >> 1) + 128 * (dd >> 6) + 32 * (2 * (Hh & 1) + (rr >> 5)) + (rr & 31); }
          if (j.pmode == 2) { const int Hh = ng >> 6, dd = ng & 63; nd = 256 * (Hh >> 2) + 128 * (dd >> 5) + 32 * (Hh & 3) + (dd & 31); }
          if (j.mul8 != 0.f) { const float m8 = j.mul8; const u32x2 w8 = {cvt4_fp8(s[0] * m8, s[65] * m8, s[130] * m8, s[195] * m8), cvt4_fp8(s[260] * m8, s[325] * m8, s[390] * m8, s[455] * m8)};
              *(u32x2*)((unsigned char*)j.dst + (size_t)nd * j.lddst + k0 + k8) = w8; }
          else *(u32x4*)(j.dst + (size_t)nd * j.lddst + k0 + k8) = w; }
        __syncthreads();
    }
    cursor += nt;
}
DEVI CvtJob mkjob(const float* src, int K, int N, bf16_t* dst, int lddst, int off = 0, int blk = 1 << 30, int bstride = 0) { CvtJob j; j.src = src; j.ld = N; j.K = K; j.N = N; j.dst = dst; j.lddst = lddst; j.blk = blk; j.bstride = bstride; j.off = off; j.pmode = 0; j.mul8 = 0.f; return j; }

DEVI void cvt_small(const P& p, float* lds) {
    int cur = 0;
    bf16_t* wqkv = WSP(bf16_t, WS_WQKV); bf16_t* wo = WSP(bf16_t, WS_WO); bf16_t* wrkv = WSP(bf16_t, WS_WRKV); bf16_t* wl1 = WSP(bf16_t, WS_WL1); bf16_t* wl2 = WSP(bf16_t, WS_WL2);
    { CvtJob j = mkjob(p.a_w_qkv, 1024, 1536, wqkv, 1024); j.pmode = 1; j.mul8 = F1_MUL; cvt_run(j, cur, lds); }
    { CvtJob j = mkjob(p.b_w_qkv, 1024, 1536, wqkv + (size_t)1536 * 1024, 1024); j.pmode = 2; j.mul8 = F1_MUL; cvt_run(j, cur, lds); }
    { CvtJob j = mkjob(p.a_w_qkv + (size_t)1024 * 1536, 1024, 1536, wqkv + (size_t)2 * 1536 * 1024, 1024); j.pmode = 1; j.mul8 = F1_MUL; cvt_run(j, cur, lds); }
    cvt_run(mkjob(p.a_w_o, 1024, 1024, wo, 1024), cur, lds);
    cvt_run(mkjob(p.b_w_o, 1024, 1024, wo + (size_t)1 * 1024 * 1024, 1024), cur, lds);
    cvt_run(mkjob(p.c_w_o, 1024, 1024, wo + (size_t)2 * 1024 * 1024, 1024), cur, lds);
    cvt_run(mkjob(p.a_w_o + (size_t)1024 * 1024, 1024, 1024, wo + (size_t)3 * 1024 * 1024, 1024), cur, lds);
    for (int i = 0; i < 3; ++i) cvt_run(mkjob(p.c_w_rkv + (size_t)i * 1024 * 1024, 1024, 1024, wrkv + (size_t)i * 1024 * 1024, 1024), cur, lds);
    for (int d = 0; d < 2; ++d) cvt_run(mkjob(p.c_w1 + (size_t)d * 1024 * 64, 1024, 64, wl1, 1024, 64 * d), cur, lds);
    for (int d = 0; d < 2; ++d) cvt_run(mkjob(p.c_a1 + (size_t)d * 1024 * 64, 1024, 64, wl1 + (size_t)256 * 1024, 1024, 64 * d), cur, lds);
    cvt_run(mkjob(p.c_g1, 1024, 128, wl1 + (size_t)2 * 256 * 1024, 1024), cur, lds);
    for (int d = 0; d < 2; ++d) cvt_run(mkjob(p.c_w2 + (size_t)d * 64 * 1024, 64, 1024, wl2 + (size_t)(d * 1024) * 256 + 64 * d, 256), cur, lds);
    for (int d = 0; d < 2; ++d) cvt_run(mkjob(p.c_a2 + (size_t)d * 64 * 1024, 64, 1024, wl2 + (size_t)((2 + d) * 1024) * 256 + 128 + 64 * d, 256), cur, lds);
    cvt_run(mkjob(p.c_g2, 128, 1024, wl2 + (size_t)4096 * 256, 128), cur, lds);
    { const int gt = BIDX * NTHREADS + TIDX, gn = gridDim.x * NTHREADS; const u32x4 z = {0u, 0u, 0u, 0u};
      for (int i = gt; i < 3 * 128 * 128; i += gn) { const int mtx = i / (128 * 128), rm = i % (128 * 128); *(u32x4*)(wl1 + ((size_t)mtx * 256 + 128 + rm / 128) * 1024 + (rm % 128) * 8) = z; }
      for (int i = gt; i < 4096 * 32; i += gn) { const int n = i >> 5, c = i & 31; if ((c >> 3) != (n >> 10)) *(u32x4*)(wl2 + (size_t)n * 256 + c * 8) = z; } }
}
constexpr int CV_ALL = NE * 1536, CV_A = 32 * 192, CV_B = 24 * 208, CV_C = 24 * 224;
static_assert(CV_A <= NE * 1024 && CV_A + CV_B + CV_C <= CV_ALL, "conversion ranges");
DEVI void cvt_ffn(const P& p, int l, float* lds, int t0, int t1, int rank, int nblk) {
    constexpr int TB = 4;
    const int tid = TIDX, kk = tid >> 3, c8 = (tid & 7) * 8;
    unsigned char* f1 = WSP(unsigned char, WS_F1); unsigned char* f2 = WSP(unsigned char, WS_F2);
    for (int g = t0 + rank; g < t1; g += TB * nblk) {
        f32x4 a[TB], b[TB];
#pragma unroll
        for (int q = 0; q < TB; ++q) { const int gq = g + q * nblk, gc = gq < t1 ? gq : g; const float* s;
            if (gc < NE * 1024) { const int e = gc >> 10, r = gc & 1023, t = r & 511; s = ((r >> 9) ? p.ffn_w3 : p.ffn_w1) + ((size_t)l * NE + e) * 1024 * 2048 + (size_t)((t >> 5) * 64 + kk) * 2048 + (t & 31) * 64 + c8; }
            else { const int g2 = gc - NE * 1024, e = g2 >> 9, t = g2 & 511; s = p.ffn_w2 + ((size_t)l * NE + e) * 1024 * 2048 + (size_t)((t >> 4) * 64 + kk) * 1024 + (t & 15) * 64 + c8; }
            a[q] = *(const f32x4*)s; b[q] = *(const f32x4*)(s + 4); }
#pragma unroll
        for (int q = 0; q < TB; ++q) { float* d = lds + q * (64 * 65) + kk * 65 + c8;
            d[0] = a[q][0]; d[1] = a[q][1]; d[2] = a[q][2]; d[3] = a[q][3]; d[4] = b[q][0]; d[5] = b[q][1]; d[6] = b[q][2]; d[7] = b[q][3]; }
        __syncthreads();
#pragma unroll
        for (int q = 0; q < TB; ++q) { const int gq = g + q * nblk;
            if (gq < t1) { const int n = tid >> 3, k8 = (tid & 7) * 8; const float* sl = lds + q * (64 * 65) + k8 * 65 + n;
                const bool isf1 = gq < NE * 1024; const float sc = isf1 ? F1_MUL : F2_MUL;
                const u32x2 w = {cvt4_fp8(sl[0] * sc, sl[65] * sc, sl[130] * sc, sl[195] * sc), cvt4_fp8(sl[260] * sc, sl[325] * sc, sl[390] * sc, sl[455] * sc)};
                unsigned char* d;
                if (isf1) { const int e = gq >> 10, r = gq & 1023, t = r & 511, ng = (t & 31) * 64 + n, nd = (ng >> 7) * 256 + (ng & 127) + 128 * (r >> 9); d = f1 + (size_t)e * 4096 * 1024 + (size_t)nd * 1024 + (t >> 5) * 64 + k8; }
                else { const int g2 = gq - NE * 1024, e = g2 >> 9, t = g2 & 511; d = f2 + (size_t)e * 1024 * 2048 + (size_t)((t & 15) * 64 + n) * 2048 + (t >> 4) * 64 + k8; }
                *(u32x2*)d = w; } }
        __syncthreads();
    }
}
DEVI bool cv_in_tail(int part, int l) { return part == 0 ? l >= 1 : (part == 1 ? l % 3 != 2 : (part == 2 ? l != DEPTH - 1 : false)); }
DEVI int cv_lo(int part) { return part == 0 ? 0 : (part == 1 ? CV_A : (part == 2 ? CV_A + CV_B : CV_A + CV_B + CV_C)); }
DEVI int cv_hi(int part) { return part == 3 ? CV_ALL : cv_lo(part + 1); }
DEVI void cvt_ffn_norm1(const P& p, int l, float* lds) {
    for (int part = 0; part < 4; ++part) if (!cv_in_tail(part, l)) cvt_ffn(p, l, lds, cv_lo(part), cv_hi(part), (int)BIDX, (int)gridDim.x);
}
DEVI void cvt_ffn_tail(const P& p, int l, float* lds, int part, int nunits) {
    const int nbusy = nunits % (int)gridDim.x;
    if (cv_in_tail(part, l) && (int)BIDX >= nbusy) cvt_ffn(p, l, lds, cv_lo(part), cv_hi(part), (int)BIDX - nbusy, (int)gridDim.x - nbusy);
}

DEVI void ph_prologue(const P& p, float* lds) {
    const int tid = TIDX, G = gridDim.x;
    float* rope = WSP(float, WS_ROPE);
    for (int i = BIDX * NTHREADS + tid; i < 64 * 32 + 64 * 16; i += G * NTHREADS) {
        int pos, f, nf; if (i < 64 * 32) { pos = i / 32; f = i % 32; nf = 32; } else { const int j = i - 64 * 32; pos = j / 16; f = j % 16; nf = 16; }
        const float inv = (float)pow(10000.0, -(double)f / (double)nf); const float ang = (float)pos * inv;
        rope[2 * i] = (float)cos((double)ang); rope[2 * i + 1] = (float)sin((double)ang);
    }
    float* cond = lds;
    float* red = lds + 9 * 1024;
    for (int i = tid; i < 9 * 1024; i += NTHREADS) { const int s = i >> 10, k = i & 1023; const float v = s < 8 ? p.c[s * 1024 + k] : p.c_ctx[k]; cond[i] = siluf_(v); }
    __syncthreads();
    float* modv = WSP(float, WS_MODV);
    for (int item = BIDX; item < DEPTH * 96; item += G) {
        const int l = item / 96, n0 = (item % 96) * 64, cg = tid & 63, kg = tid >> 6;
        float acc[9];
#pragma unroll
        for (int s = 0; s < 9; ++s) acc[s] = 0.f;
        const float* w = p.mod_w + ((size_t)l * 1024 + kg * 128) * 6144 + n0 + cg;
        for (int k = 0; k < 128; ++k) { const float wv = w[(size_t)k * 6144];
#pragma unroll
            for (int s = 0; s < 9; ++s) acc[s] += cond[s * 1024 + kg * 128 + k] * wv; }
#pragma unroll
        for (int s = 0; s < 9; ++s) red[(kg * 9 + s) * 64 + cg] = acc[s];
        __syncthreads();
        for (int o = tid; o < 9 * 64; o += NTHREADS) { const int s = o >> 6, c = o & 63; float v = 0.f;
#pragma unroll
            for (int g = 0; g < 8; ++g) v += red[(g * 9 + s) * 64 + c];
            modv[((size_t)l * 9 + s) * 6144 + n0 + c] = v + p.mod_b[l * 6144 + n0 + c]; }
        __syncthreads();
    }
    cvt_small(p, lds);
}

constexpr size_t WS_ZROW = 40960;
DEVI float row_rinv(const f32x4 (&x)[4]) { float ss = 0.f;
#pragma unroll
    for (int i = 0; i < 4; ++i) ss += x[i][0] * x[i][0] + x[i][1] * x[i][1] + x[i][2] * x[i][2] + x[i][3] * x[i][3];
    ss = wave_sum(ss); return rsqrtf(ss * (1.f / 1024.f) + 1e-6f); }
template <bool STOREX = true, class F>
DEVI void for_rows_updated(const P& p, int l, int nrows, F&& f) {
    const int lane = TIDX & 63, gw = BIDX * NWAVES + (TIDX >> 6), nw = gridDim.x * NWAVES;
    bf16_t* Xb = WSP(bf16_t, WS_X); const int* SL = WSP(int, WS_SLOT); const bf16_t* yexp = WSP(bf16_t, WS_YEXP); const bf16_t* zrow = WSP(bf16_t, WS_ZROW);
    u32x4 xn[4]; int sn = -1;
    auto ld = [&](int row) {
        if (l == 0) { const float* src = (row < RL ? p.x + (size_t)row * D : p.ctx + (size_t)(row - RL) * D);
#pragma unroll
            for (int i = 0; i < 4; ++i) xn[i] = *(const u32x4*)(src + 4 * lane + 256 * i); }
        else {
#pragma unroll
            for (int i = 0; i < 4; ++i) { const u32x2 w = *(const u32x2*)(Xb + (size_t)row * D + 4 * lane + 256 * i); xn[i][0] = w[0]; xn[i][1] = w[1]; }
            sn = SL[(size_t)(lane & 15) * R + row]; } };
    if (gw < nrows) ld(gw);
    for (int row = gw; row < nrows; row += nw) {
        f32x4 x[4]; const int sv = sn;
#pragma unroll
        for (int i = 0; i < 4; ++i) x[i] = l == 0 ? __builtin_bit_cast(f32x4, xn[i]) : (f32x4){bflo(xn[i][0]), bfhi(xn[i][0]), bflo(xn[i][1]), bfhi(xn[i][1])};
        if (row + nw < nrows) ld(row + nw);
        f32x4 gv[4], m0[4], m1[4];
        if (l < DEPTH) { const float* mvp = WSP(float, WS_MODV) + ((size_t)l * 9 + samp_of_row(row)) * 6144 + 4 * lane;
#pragma unroll
            for (int i = 0; i < 4; ++i) { m0[i] = *(const f32x4*)(mvp + 256 * i); m1[i] = *(const f32x4*)(mvp + 1024 + 256 * i); } }
        if (l > 0) { const float* g = WSP(float, WS_MODV) + ((size_t)(l - 1) * 9 + samp_of_row(row)) * 6144 + 5 * 1024 + 4 * lane;
#pragma unroll
            for (int i = 0; i < 4; ++i) gv[i] = *(const f32x4*)(g + 256 * i); }
        if (l > 0) {
            unsigned m = (unsigned)(__ballot(sv >= 0) & 0xFFFFull);
            f32x4 acc[4];
#pragma unroll
            for (int i = 0; i < 4; ++i) acc[i] = (f32x4){0.f, 0.f, 0.f, 0.f};
            while (m) {
                const int e0 = __builtin_ctz(m); m &= m - 1; const bool two = m != 0; const int e1 = two ? __builtin_ctz(m) : 0; if (two) m &= m - 1;
                const int s0 = __builtin_amdgcn_readlane(sv, e0), s1 = __builtin_amdgcn_readlane(sv, e1);
                const bf16_t* y0 = yexp + ((size_t)e0 * EROWS + s0) * D + 4 * lane; const bf16_t* y1 = two ? yexp + ((size_t)e1 * EROWS + s1) * D + 4 * lane : zrow + 4 * lane;
                u32x2 w0[4], w1[4];
#pragma unroll
                for (int i = 0; i < 4; ++i) { w0[i] = *(const u32x2*)(y0 + 256 * i); w1[i] = *(const u32x2*)(y1 + 256 * i); }
#pragma unroll
                for (int i = 0; i < 4; ++i) { acc[i][0] += bflo(w0[i][0]) + bflo(w1[i][0]); acc[i][1] += bfhi(w0[i][0]) + bfhi(w1[i][0]); acc[i][2] += bflo(w0[i][1]) + bflo(w1[i][1]); acc[i][3] += bfhi(w0[i][1]) + bfhi(w1[i][1]); }
            }
#pragma unroll
            for (int i = 0; i < 4; ++i) x[i] = x[i] + gv[i] * acc[i];
        }
        if (STOREX && l < DEPTH) {
#pragma unroll
            for (int i = 0; i < 4; ++i) { const u32x2 w = {cvt_pk_bf16(x[i][0], x[i][1]), cvt_pk_bf16(x[i][2], x[i][3])}; *(u32x2*)(Xb + (size_t)row * D + 4 * lane + 256 * i) = w; } }
        f(row, lane, x, m0, m1);
    }
}
template <bool STOREX = true>
DEVI void ph_norm1(const P& p, int l) {
    for_rows_updated<STOREX>(p, l, R, [&](int row, int lane, const f32x4 (&x)[4], const f32x4 (&m0)[4], const f32x4 (&m1)[4]) {
        const float ri = row_rinv(x);
#pragma unroll
        for (int i = 0; i < 4; ++i) { const f32x4 sh = m0[i], sc = m1[i]; const f32x4 h = x[i] * ri * (sc + 1.f) + sh;
            if (l % 3 != 2) *(unsigned*)(WSP(unsigned char, WS_H) + (size_t)row * D + 4 * lane + 256 * i) = cvt4_fp8(h[0], h[1], h[2], h[3]);
            else { u32x2 w = {cvt_pk_bf16(h[0], h[1]), cvt_pk_bf16(h[2], h[3])}; *(u32x2*)(WSP(bf16_t, WS_H) + (size_t)row * D + 4 * lane + 256 * i) = w; } } });
}
DEVI void ph_norm2(const P& p, int l, float* lds) {
    const int tid = TIDX, lane = tid & 63, gw = BIDX * NWAVES + (tid >> 6), nw = gridDim.x * NWAVES, NR = (l == DEPTH - 1) ? RL : R;
    for (int k = tid; k < 1024; k += NTHREADS) { const f32x4* src = (const f32x4*)(p.router_w + ((size_t)l * 1024 + k) * 16); const f32x4 a = src[0], b = src[1], c = src[2], d = src[3];
        lds[0 * 1024 + k] = a[0]; lds[1 * 1024 + k] = a[1]; lds[2 * 1024 + k] = a[2]; lds[3 * 1024 + k] = a[3]; lds[4 * 1024 + k] = b[0]; lds[5 * 1024 + k] = b[1]; lds[6 * 1024 + k] = b[2]; lds[7 * 1024 + k] = b[3];
        lds[8 * 1024 + k] = c[0]; lds[9 * 1024 + k] = c[1]; lds[10 * 1024 + k] = c[2]; lds[11 * 1024 + k] = c[3]; lds[12 * 1024 + k] = d[0]; lds[13 * 1024 + k] = d[1]; lds[14 * 1024 + k] = d[2]; lds[15 * 1024 + k] = d[3]; }
    __syncthreads();
    u32x2 xn[4], xm[4];
    if (gw < NR) {
#pragma unroll
        for (int i = 0; i < 4; ++i) xn[i] = *(const u32x2*)(WSP(bf16_t, WS_X) + (size_t)gw * D + 4 * lane + 256 * i); }
    if (gw + nw < NR) {
#pragma unroll
        for (int i = 0; i < 4; ++i) xm[i] = *(const u32x2*)(WSP(bf16_t, WS_X) + (size_t)(gw + nw) * D + 4 * lane + 256 * i); }
    for (int row = gw; row < NR; row += nw) {
        f32x4 x[4];
#pragma unroll
        for (int i = 0; i < 4; ++i) { x[i] = (f32x4){bflo(xn[i][0]), bfhi(xn[i][0]), bflo(xn[i][1]), bfhi(xn[i][1])}; xn[i] = xm[i]; }
        if (row + 2 * nw < NR) {
#pragma unroll
            for (int i = 0; i < 4; ++i) xm[i] = *(const u32x2*)(WSP(bf16_t, WS_X) + (size_t)(row + 2 * nw) * D + 4 * lane + 256 * i); }
        const float ri = row_rinv(x);
        const float* mv = WSP(float, WS_MODV) + ((size_t)l * 9 + samp_of_row(row)) * 6144 + 3 * 1024 + 4 * lane;
        f32x2 lg2[16];
#pragma unroll
        for (int e = 0; e < 16; ++e) lg2[e] = (f32x2){0.f, 0.f};
        f32x4 shv[4], scv[4];
#pragma unroll
        for (int i = 0; i < 4; ++i) { shv[i] = *(const f32x4*)(mv + 256 * i); scv[i] = *(const f32x4*)(mv + 1024 + 256 * i); }
#pragma unroll
        for (int i = 0; i < 4; ++i) { const f32x4 sh = shv[i], sc = scv[i]; const f32x4 h = x[i] * ri * (sc + 1.f) + sh;
            *(unsigned*)(WSP(unsigned char, WS_H) + (size_t)row * D + 4 * lane + 256 * i) = cvt4_fp8(h[0], h[1], h[2], h[3]);
            const f32x2 h01 = {h[0], h[1]}, h23 = {h[2], h[3]};
#pragma unroll
            for (int e = 0; e < 16; ++e) { const f32x4 wv = *(const f32x4*)(lds + e * 1024 + 4 * lane + 256 * i); lg2[e] = lg2[e] + h01 * (f32x2){wv[0], wv[1]} + h23 * (f32x2){wv[2], wv[3]}; }
            asm volatile("" ::: "memory"); }
#define DPPF(x, ctrl) __builtin_bit_cast(float, __builtin_amdgcn_update_dpp(0, __builtin_bit_cast(int, x), ctrl, 0xF, 0xF, true))
        float s1[8], s2[4]; const bool p0 = lane & 1, p1 = lane & 2;
#pragma unroll
        for (int k = 0; k < 8; ++k) { const float a = lg2[2 * k][0] + lg2[2 * k][1], b = lg2[2 * k + 1][0] + lg2[2 * k + 1][1]; const float send = p0 ? a : b, keep = p0 ? b : a; s1[k] = keep + DPPF(send, 0xB1); }
#pragma unroll
        for (int m = 0; m < 4; ++m) { const float send = p1 ? s1[2 * m] : s1[2 * m + 1], keep = p1 ? s1[2 * m + 1] : s1[2 * m]; float v = keep + DPPF(send, 0x4E);
            v += DPPF(v, 0x124); v += DPPF(v, 0x128);
            { auto r = __builtin_amdgcn_permlane16_swap(__float_as_uint(v), __float_as_uint(v), false, false); v = __uint_as_float(r[0]) + __uint_as_float(r[1]); }
            { auto r = __builtin_amdgcn_permlane32_swap(__float_as_uint(v), __float_as_uint(v), false, false); v = __uint_as_float(r[0]) + __uint_as_float(r[1]); }
            s2[m] = v; }
        float mx = fmaxf(fmaxf(s2[0], s2[1]), fmaxf(s2[2], s2[3])); mx = fmaxf(mx, DPPF(mx, 0xB1)); mx = fmaxf(mx, DPPF(mx, 0x4E));
        float ex[4], se = 0.f;
#pragma unroll
        for (int m = 0; m < 4; ++m) { ex[m] = __builtin_amdgcn_exp2f((s2[m] - mx) * 1.4426950408889634f); se += ex[m]; }
        se += DPPF(se, 0xB1); se += DPPF(se, 0x4E);
#undef DPPF
        if (lane < 4) { const float inv = 1.f / se;
#pragma unroll
            for (int m = 0; m < 4; ++m) WSP(float, WS_AFF)[(size_t)row * 16 + 4 * m + lane] = ex[m] * inv; }
    }
    __syncthreads();
}
DEVI void ph_final(const P& p) {
    for_rows_updated(p, DEPTH, RL, [&](int row, int lane, const f32x4 (&x)[4], const f32x4 (&)[4], const f32x4 (&)[4]) {
        const float ri = row_rinv(x);
#pragma unroll
        for (int i = 0; i < 4; ++i) *(f32x4*)(p.out + (size_t)row * D + 4 * lane + 256 * i) = x[i] * ri * *(const f32x4*)(p.final_norm + 4 * lane + 256 * i); });
}

template <class Epi>
DEVI void gemm_wave_tile(const bf16_t* __restrict__ A, int lda, const int* __restrict__ gidx, const bf16_t* __restrict__ Bt, int ldb, int K, int m0, int n0, int noff, const Epi& epi, int orow0) {
    const int lane = TIDX & 63, r32 = lane & 31, hi = lane >> 5;
    const size_t ra0 = gidx ? (size_t)gidx[m0 + r32] : (size_t)(m0 + r32), ra1 = gidx ? (size_t)gidx[m0 + 32 + r32] : (size_t)(m0 + 32 + r32);
    const bf16_t* a0p = A + ra0 * lda + hi * 8; const bf16_t* a1p = A + ra1 * lda + hi * 8;
    const bf16_t* b0p = Bt + (size_t)(n0 + r32) * ldb + hi * 8; const bf16_t* b1p = Bt + (size_t)(n0 + noff + r32) * ldb + hi * 8;
    f32x16 c00 = {}, c01 = {}, c10 = {}, c11 = {};
    for (int k = 0; k < K; k += 16) {
        const bf16x8 a0 = *(const bf16x8*)(a0p + k), a1 = *(const bf16x8*)(a1p + k), b0 = *(const bf16x8*)(b0p + k), b1 = *(const bf16x8*)(b1p + k);
        c00 = __builtin_amdgcn_mfma_f32_32x32x16_bf16(a0, b0, c00, 0, 0, 0); c01 = __builtin_amdgcn_mfma_f32_32x32x16_bf16(a0, b1, c01, 0, 0, 0);
        c10 = __builtin_amdgcn_mfma_f32_32x32x16_bf16(a1, b0, c10, 0, 0, 0); c11 = __builtin_amdgcn_mfma_f32_32x32x16_bf16(a1, b1, c11, 0, 0, 0);
    }
#pragma unroll
    for (int r = 0; r < 16; ++r) { const int rr = crow(r, hi);
        if constexpr (Epi::PAIRED) { epi.pair(orow0 + m0 + rr, n0 + r32, c00[r], c01[r]); epi.pair(orow0 + m0 + 32 + rr, n0 + r32, c10[r], c11[r]); }
        else { epi(orow0 + m0 + rr, n0 + r32, c00[r]); epi(orow0 + m0 + rr, n0 + noff + r32, c01[r]); epi(orow0 + m0 + 32 + rr, n0 + r32, c10[r]); epi(orow0 + m0 + 32 + rr, n0 + noff + r32, c11[r]); } }
}
template <class Epi>
DEVI void gemm_all(const bf16_t* A, int lda, const bf16_t* Bt, int ldb, int M, int N, int K, const Epi& epi, int& cur) {
    const int gw = BIDX * NWAVES + (TIDX >> 6), nw = gridDim.x * NWAVES, tn = N / 64, nt = (M / 64) * tn;
    const int first = (gw - (cur % nw) + nw) % nw;
    for (int t = first; t < nt; t += nw) gemm_wave_tile(A, lda, nullptr, Bt, ldb, K, (t / tn) * 64, (t % tn) * 64, 32, epi, 0);
    cur += nt;
}

struct EpiF32 { static constexpr bool PAIRED = false; float* C; int ldc; DEVI void operator()(int row, int col, float v) const { C[(size_t)row * ldc + col] = v; } };
template <int ACT> struct EpiBf16 { static constexpr bool PAIRED = false; bf16_t* C; int ldc;
    DEVI void operator()(int row, int col, float v) const { if (ACT == 1) v = tanhf_(v); if (ACT == 2) v = sigmoidf_(v); C[(size_t)row * ldc + col] = f2bf(v); } };
struct EpiResid { static constexpr bool PAIRED = false; float* X; const float* gate;
    DEVI void operator()(int row, int col, float v) const { float* x = X + (size_t)row * D + col; *x += gate[(size_t)samp_of_row(row) * 6144 + col] * v; } };
struct EpiSwiGLU { static constexpr bool PAIRED = true; bf16_t* H;
    DEVI void pair(int row, int ncol, float g, float u) const { const int hc = (ncol >> 8) * 128 + (ncol & 255); H[(size_t)row * FF + hc] = f2bf(siluf_(g) * u); } };
struct EpiGate { static constexpr bool PAIRED = false; bf16_t* Y; const float* gate;
    DEVI void operator()(int row, int col, float v) const { Y[(size_t)row * D + col] = f2bf(gate[row] * v); } };
struct EpiDecay { static constexpr bool PAIRED = false; float* W; const float* w0;
    DEVI void operator()(int row, int col, float v) const { W[(size_t)row * D + col] = __expf(-0.6065306597126334f * sigmoidf_(w0[col] + v)); } };
struct EpiSig { static constexpr bool PAIRED = false; float* W; const float* a0;
    DEVI void operator()(int row, int col, float v) const { W[(size_t)row * D + col] = sigmoidf_(a0[col] + v); } };

namespace g8 {
constexpr int BM = 256, BK = 64, HALF = 128, HTB = HALF * BK * 2, STAGE_BYTES = 8 * HTB;
DEVI int lds_byte(int r, int c) { const int st = (r >> 4) * 2 + (c >> 5), rr = r & 15, cc = c & 31, ob = rr * 64 + cc * 2; return st * 1024 + (ob ^ (((ob >> 9) & 1) << 5)); }
DEVI void stage_rc(int b, int& Rr, int& Cc) { const int st = b / 1024, sb = b % 1024, swz = sb ^ (((sb >> 9) & 1) << 5); Rr = (st >> 1) * 16 + swz / 64; Cc = (st & 1) * 32 + (swz % 64) / 2; }
DEVI int perm32(int rho) { const int n = rho >> 4, i = rho & 15; return 8 * (i >> 2) + 4 * n + (i & 3); }
struct Unit { const char* A; const char* B; const int* gidx; int pm, pn, e; };
DEVI float ld_f32_uncounted(const float* p) { float v; asm volatile("global_load_dword %0, %1, off" : "=v"(v) : "v"(p) : "memory"); return v; }
DEVI int ld_i32_uncounted(const int* p) { int v; asm volatile("global_load_dword %0, %1, off" : "=v"(v) : "v"(p) : "memory"); return v; }
DEVI const char* uptr(const char* p) { const unsigned long long v = (unsigned long long)p; const unsigned lo = __builtin_amdgcn_readfirstlane((unsigned)v), hi = __builtin_amdgcn_readfirstlane((unsigned)(v >> 32)); return (const char*)(((unsigned long long)hi << 32) | lo); }
template <class Epi, class Sched, bool GATHER = false, bool F8 = false>
DEVI void gemm_phase(LAS unsigned char* lds, const int K, const Sched& S, const Epi& E, const int wscale = 0x7F7F7F7F) {
    const int tid = TIDX, wid = __builtin_amdgcn_readfirstlane(tid >> 6), lane = tid & 63, wr = wid >> 2, wc = wid & 3, fr = lane & 15, fq = lane >> 4;
    const int nt = K / BK;
    unsigned voffB[2]; int rowA[2], colA[2];
#pragma unroll
    for (int i = 0; i < 2; ++i) { int Rr, Cc; stage_rc(tid * 16 + i * 8192, Rr, Cc); const int Rb = Epi::PERM ? ((Rr & ~31) + perm32(Rr & 31)) : Rr;
        rowA[i] = Rr; colA[i] = Cc; voffB[i] = (unsigned)(Rb * K + Cc) * 2u; }
    const size_t kstep = (size_t)(BK * 2), hstep = (size_t)HALF * K * 2;
    unsigned oc[2][2], on[2][2]; int ri[2][2];
#define G8_AOFF(dst, u) do { _Pragma("unroll") for (int _h = 0; _h < 2; ++_h) _Pragma("unroll") for (int _i = 0; _i < 2; ++_i) \
        dst[_h][_i] = (unsigned)((GATHER ? (u).gidx[_h * HALF + rowA[_i]] : (_h * HALF + rowA[_i])) * K + colA[_i]) * 2u; } while (0)
    const unsigned ldsw = (unsigned)wid * 1024u;
    const int aoff = lds_byte(wr * 64 + fr, fq * 8), boff = lds_byte(wc * 32 + fr, fq * 8);
#define G8_SA(b, h) (((b) * 2 + (h)) * HTB)
#define G8_SB(b, h) ((4 + (b) * 2 + (h)) * HTB)
#define G8_STAGE(bufoff, gbase, voff) do { _Pragma("unroll") for (int _i = 0; _i < 2; ++_i) \
        __builtin_amdgcn_global_load_lds((const unsigned*)((const char*)(gbase) + (voff)[_i]), (LAS unsigned*)(lds + (bufoff) + ldsw + _i * 8192), 16, 0, 0); } while (0)
#define G8_LDA(dst, b, h) do { _Pragma("unroll") for (int m = 0; m < 4; ++m) _Pragma("unroll") for (int k = 0; k < 2; ++k) dst[m][k] = *(const LAS bf16x8*)(lds + G8_SA(b, h) + aoff + m * 2048 + k * 1024); } while (0)
#define G8_LDB(dst, b, h) do { _Pragma("unroll") for (int n = 0; n < 2; ++n) _Pragma("unroll") for (int k = 0; k < 2; ++k) dst[n][k] = *(const LAS bf16x8*)(lds + G8_SB(b, h) + boff + n * 2048 + k * 1024); } while (0)
#define G8_CAT(v) __builtin_shufflevector(__builtin_bit_cast(i32x4, v[0]), __builtin_bit_cast(i32x4, v[1]), 0, 1, 2, 3, 4, 5, 6, 7)
#define G8_MMA(ai, bj, At, Bt) do { __builtin_amdgcn_s_setprio(1); \
        if constexpr (F8) { _Pragma("unroll") for (int m = 0; m < 4; ++m) _Pragma("unroll") for (int n = 0; n < 2; ++n) \
            asm volatile("v_mfma_scale_f32_16x16x128_f8f6f4 %0, %1, %2, %0, %3, %4 op_sel_hi:[0,0,0]" : "+v"(acc[ai][bj][m][n]) : "v"(G8_CAT(Bt[n])), "v"(G8_CAT(At[m])), "v"(wsc), "v"(one)); } \
        else { _Pragma("unroll") for (int m = 0; m < 4; ++m) _Pragma("unroll") for (int n = 0; n < 2; ++n) _Pragma("unroll") for (int k = 0; k < 2; ++k) \
            acc[ai][bj][m][n] = __builtin_amdgcn_mfma_f32_16x16x32_bf16(Bt[n][k], At[m][k], acc[ai][bj][m][n], 0, 0, 0); } \
        __builtin_amdgcn_s_setprio(0); } while (0)
#define G8_WAIT_V(n) asm volatile("s_waitcnt vmcnt(" #n ")" ::: "memory")
#define G8_WAIT_L(n) asm volatile("s_waitcnt lgkmcnt(" #n ")" ::: "memory")
#define G8_BAR __builtin_amdgcn_s_barrier()
#define G8_SCHED __builtin_amdgcn_sched_barrier(0)
    Unit cur, nxt; int ui = 0;
    if (!S.next(0, cur)) return;
    f32x4 acc[2][2][4][2];
#pragma unroll
    for (int a = 0; a < 2; ++a)
#pragma unroll
        for (int b = 0; b < 2; ++b)
#pragma unroll
            for (int m = 0; m < 4; ++m)
#pragma unroll
                for (int n = 0; n < 2; ++n) acc[a][b][m][n] = (f32x4){0.f, 0.f, 0.f, 0.f};
    bf16x8 At[4][2], B0[2][2], B1[2][2];
    int wsc = wscale, one = 0x7F7F7F7F; asm volatile("" : "+v"(wsc), "+v"(one));
    const char* cA = uptr(cur.A); const char* cB = uptr(cur.B);
    G8_AOFF(oc, cur);
    G8_STAGE(G8_SB(0, 0), cB, voffB); G8_STAGE(G8_SA(0, 0), cA, oc[0]); G8_STAGE(G8_SB(0, 1), cB + hstep, voffB); G8_STAGE(G8_SA(0, 1), cA, oc[1]);
    if (wr == 1) G8_BAR;
    G8_WAIT_V(4); G8_BAR;
    G8_STAGE(G8_SB(1, 0), cB + kstep, voffB); G8_STAGE(G8_SA(1, 0), cA + kstep, oc[0]); G8_STAGE(G8_SB(1, 1), cB + hstep + kstep, voffB);
    G8_WAIT_V(6); G8_BAR;
    for (;;) {
        const bool has_next = S.next(ui + 1, nxt);
        float pfv[8]; if constexpr (Epi::HAS_PRE) E.pre(cur, wr, wc, fr, fq, pfv);
        const char* nA = uptr(has_next ? nxt.A : cA); const char* nB = uptr(has_next ? nxt.B : cB);
        if (GATHER) { const int* ng = has_next ? nxt.gidx : cur.gidx;
            _Pragma("unroll") for (int _h = 0; _h < 2; ++_h) _Pragma("unroll") for (int _i = 0; _i < 2; ++_i) ri[_h][_i] = ld_i32_uncounted(ng + _h * HALF + rowA[_i]); }
#pragma unroll 1
        for (int t = 0; t < nt; t += 2) {
            const bool last = (t == nt - 2);
            const char* a1 = cA + (size_t)(t + 1) * kstep;
            const char* a2 = last ? nA : cA + (size_t)(t + 2) * kstep; const char* b2 = last ? nB : cB + (size_t)(t + 2) * kstep;
            const char* a3 = a2 + kstep; const char* b3 = b2 + kstep;
            unsigned o2[2][2];
            if constexpr (GATHER) {
                if (last) { _Pragma("unroll") for (int _h = 0; _h < 2; ++_h) _Pragma("unroll") for (int _i = 0; _i < 2; ++_i) { int _rv = ri[_h][_i]; asm volatile("" : "+v"(_rv)); on[_h][_i] = (unsigned)(_rv * K + colA[_i]) * 2u; } }
                _Pragma("unroll") for (int _h = 0; _h < 2; ++_h) _Pragma("unroll") for (int _i = 0; _i < 2; ++_i) o2[_h][_i] = last ? on[_h][_i] : oc[_h][_i];
            } else { _Pragma("unroll") for (int _h = 0; _h < 2; ++_h) _Pragma("unroll") for (int _i = 0; _i < 2; ++_i) o2[_h][_i] = oc[_h][_i]; }
            G8_LDB(B0, 0, 0); G8_SCHED; G8_LDA(At, 0, 0); G8_STAGE(G8_SA(1, 1), a1, oc[1]);
            G8_WAIT_L(8); G8_BAR; G8_WAIT_L(0); G8_MMA(0, 0, At, B0); G8_BAR; G8_SCHED;
            G8_LDB(B1, 0, 1); G8_STAGE(G8_SB(0, 0), b2, voffB);
            G8_BAR; G8_WAIT_L(0); G8_MMA(0, 1, At, B1); G8_BAR;
            G8_LDA(At, 0, 1); G8_STAGE(G8_SA(0, 0), a2, o2[0]);
            G8_BAR; G8_WAIT_L(0); G8_MMA(1, 0, At, B0); G8_BAR; G8_SCHED;
            G8_STAGE(G8_SB(0, 1), b2 + hstep, voffB);
            G8_WAIT_V(6); G8_BAR; G8_MMA(1, 1, At, B1); G8_BAR;
            G8_LDB(B0, 1, 0); G8_SCHED; G8_LDA(At, 1, 0); G8_STAGE(G8_SA(0, 1), a2, o2[1]);
            G8_WAIT_L(8); G8_BAR; G8_WAIT_L(0); G8_MMA(0, 0, At, B0); G8_BAR; G8_SCHED;
            G8_LDB(B1, 1, 1); G8_STAGE(G8_SB(1, 0), b3, voffB);
            G8_BAR; G8_WAIT_L(0); G8_MMA(0, 1, At, B1); G8_BAR;
            G8_LDA(At, 1, 1); G8_STAGE(G8_SA(1, 0), a3, o2[0]);
            G8_BAR; G8_WAIT_L(0); G8_MMA(1, 0, At, B0); G8_BAR; G8_SCHED;
            G8_STAGE(G8_SB(1, 1), b3 + hstep, voffB);
            G8_WAIT_V(6); G8_BAR; G8_MMA(1, 1, At, B1); G8_BAR;
        }
        if constexpr (F8) asm volatile("s_nop 15\n\ts_nop 15" ::: "memory");
        if constexpr (Epi::HAS_PRE) E(acc, cur, wr, wc, fr, fq, pfv); else E(acc, cur, wr, wc, fr, fq);
        if (!has_next) break;
#pragma unroll
        for (int a = 0; a < 2; ++a)
#pragma unroll
            for (int b = 0; b < 2; ++b)
#pragma unroll
                for (int m = 0; m < 4; ++m)
#pragma unroll
                    for (int n = 0; n < 2; ++n) acc[a][b][m][n] = (f32x4){0.f, 0.f, 0.f, 0.f};
        cur = nxt; cA = nA; cB = nB; ++ui;
        if constexpr (GATHER) { _Pragma("unroll") for (int _h = 0; _h < 2; ++_h) _Pragma("unroll") for (int _i = 0; _i < 2; ++_i) oc[_h][_i] = on[_h][_i]; }
    }
    G8_WAIT_V(0);
    if (wr == 0) G8_BAR;
    G8_BAR;
#undef G8_AOFF
#undef G8_SA
#undef G8_SB
#undef G8_STAGE
#undef G8_LDA
#undef G8_LDB
#undef G8_MMA
#undef G8_CAT
#undef G8_WAIT_V
#undef G8_WAIT_L
#undef G8_BAR
#undef G8_SCHED
}
DEVI int xcd_remap(int L, int n) { const int q = n / 8, r = n % 8, x = L % 8, off = L / 8; return (x < r ? x * (q + 1) : r * (q + 1) + (x - r) * q) + off; }
struct PlainOrder {
    const char *A, *B; size_t sA, sB; int ng, nM, nN, K;
    DEVI bool next(int i, Unit& u) const { const int n = ng * nM * nN; const long L = (long)i * gridDim.x + BIDX; if (L >= n) return false;
        const int id = xcd_remap((int)L, n), per = nM * nN, g = id / per, rm = id % per; u.pm = rm / nN; u.pn = rm % nN; u.e = g;
        u.A = A + (size_t)g * sA + (size_t)u.pm * 256 * K * 2; u.B = B + (size_t)g * sB + (size_t)u.pn * 256 * K * 2; u.gidx = nullptr; return true; }
};
struct ExpertOrder {
    const char* A; const char* B; const int* gidx; size_t bstride; int nM, nN, K, mstride;
    DEVI bool next(int i, Unit& u) const { const int n = NE * nM * nN; const long L = (long)i * gridDim.x + BIDX; if (L >= n) return false;
        const int id = xcd_remap((int)L, n), per = nM * nN, e = id / per, rm = id % per; u.e = e; u.pm = e * mstride + rm / nN; u.pn = rm % nN;
        u.gidx = gidx ? gidx + (size_t)u.pm * 256 : nullptr; u.A = gidx ? A : A + (size_t)u.pm * 256 * K * 2; u.B = B + (size_t)e * bstride + (size_t)u.pn * 256 * K * 2; return true; }
};
struct EpiF32 { static constexpr bool HAS_PRE = false, PERM = false; float* C; int ldc;
    DEVI void operator()(const f32x4 (&acc)[2][2][4][2], const Unit& u, int wr, int wc, int fr, int fq) const {
        float* base = C + (size_t)(u.pm * 256 + wr * 64 + fr) * ldc + u.pn * 256 + wc * 32 + 4 * fq;
#pragma unroll
        for (int ai = 0; ai < 2; ++ai)
#pragma unroll
            for (int m = 0; m < 4; ++m) { float* rp = base + (size_t)(ai * 128 + m * 16) * ldc;
#pragma unroll
                for (int bj = 0; bj < 2; ++bj)
#pragma unroll
                    for (int n = 0; n < 2; ++n) *(f32x4*)(rp + bj * 128 + n * 16) = acc[ai][bj][m][n]; } } };
struct EpiNull { static constexpr bool HAS_PRE = false, PERM = true; float* sink;
    DEVI void operator()(const f32x4 (&acc)[2][2][4][2], const Unit& u, int wr, int wc, int fr, int fq) const {
        float t = 0.f;
#pragma unroll
        for (int ai = 0; ai < 2; ++ai)
#pragma unroll
            for (int bj = 0; bj < 2; ++bj)
#pragma unroll
                for (int m = 0; m < 4; ++m)
#pragma unroll
                    for (int n = 0; n < 2; ++n) t += acc[ai][bj][m][n][0];
        if (t == 1.2345e30f) sink[0] = t; } };
DEVI u32x4 pack8(const f32x4 a, const f32x4 b) { return (u32x4){cvt_pk_bf16(a[0], a[1]), cvt_pk_bf16(a[2], a[3]), cvt_pk_bf16(b[0], b[1]), cvt_pk_bf16(b[2], b[3])}; }
struct EpiResid { static constexpr bool HAS_PRE = false, PERM = true; bf16_t* X; const float* gate;
    DEVI void operator()(const f32x4 (&acc)[2][2][4][2], const Unit& u, int wr, int wc, int fr, int fq) const {
        const int col0 = u.pn * 256 + wc * 32 + 8 * fq; const float* g = gate + (size_t)samp_of_row(u.pm * 256) * 6144 + col0;
        f32x4 gv[2][2];
#pragma unroll
        for (int bj = 0; bj < 2; ++bj)
#pragma unroll
            for (int n = 0; n < 2; ++n) gv[bj][n] = *(const f32x4*)(g + bj * 128 + n * 4);
        bf16_t* base = X + (size_t)(u.pm * 256 + wr * 64 + fr) * D + col0;
#pragma unroll
        for (int ai = 0; ai < 2; ++ai) { u32x4 xv[4][2];
#pragma unroll
            for (int m = 0; m < 4; ++m)
#pragma unroll
                for (int bj = 0; bj < 2; ++bj) xv[m][bj] = *(const u32x4*)(base + (size_t)(ai * 128 + m * 16) * D + bj * 128);
            __builtin_amdgcn_sched_barrier(0);
#pragma unroll
            for (int m = 0; m < 4; ++m)
#pragma unroll
                for (int bj = 0; bj < 2; ++bj) { const u32x4 w = xv[m][bj];
                    const f32x4 lo = (f32x4){bflo(w[0]), bfhi(w[0]), bflo(w[1]), bfhi(w[1])} + gv[bj][0] * acc[ai][bj][m][0], hi = (f32x4){bflo(w[2]), bfhi(w[2]), bflo(w[3]), bfhi(w[3])} + gv[bj][1] * acc[ai][bj][m][1];
                    *(u32x4*)(base + (size_t)(ai * 128 + m * 16) * D + bj * 128) = pack8(lo, hi); }
            __builtin_amdgcn_sched_barrier(0); } } };
struct EpiBf16 { static constexpr bool HAS_PRE = false, PERM = true; bf16_t* C; size_t sC; int ldc;
    DEVI void operator()(const f32x4 (&acc)[2][2][4][2], const Unit& u, int wr, int wc, int fr, int fq) const {
        bf16_t* c = C + (size_t)u.e * sC;
        bf16_t* base = c + (size_t)(u.pm * 256 + wr * 64 + fr) * ldc + u.pn * 256 + wc * 32 + 8 * fq;
#pragma unroll
        for (int ai = 0; ai < 2; ++ai)
#pragma unroll
            for (int m = 0; m < 4; ++m) { bf16_t* rp = base + (size_t)(ai * 128 + m * 16) * ldc;
#pragma unroll
                for (int bj = 0; bj < 2; ++bj) *(u32x4*)(rp + bj * 128) = pack8(acc[ai][bj][m][0], acc[ai][bj][m][1]); } } };
struct EpiSwiGLU { static constexpr bool HAS_PRE = false, PERM = true; unsigned char* H;
    DEVI void operator()(const f32x4 (&acc)[2][2][4][2], const Unit& u, int wr, int wc, int fr, int fq) const {
        unsigned char* base = H + (size_t)(u.pm * 256 + wr * 64 + fr) * FF + u.pn * 128 + wc * 32 + 8 * fq;
#pragma unroll
        for (int ai = 0; ai < 2; ++ai)
#pragma unroll
            for (int m = 0; m < 4; ++m) { f32x4 h[2];
#pragma unroll
                for (int n = 0; n < 2; ++n)
#pragma unroll
                    for (int j = 0; j < 4; ++j) h[n][j] = siluf_(acc[ai][0][m][n][j]) * acc[ai][1][m][n][j];
                *(u32x2*)(base + (size_t)(ai * 128 + m * 16) * FF) = (u32x2){cvt4_fp8(h[0][0], h[0][1], h[0][2], h[0][3]), cvt4_fp8(h[1][0], h[1][1], h[1][2], h[1][3])}; } } };
struct EpiGate { static constexpr bool HAS_PRE = true, PERM = true; bf16_t* Y; const float* gate;
    DEVI void pre(const Unit& u, int wr, int wc, int fr, int fq, float (&pf)[8]) const { const int row0 = u.pm * 256 + wr * 64 + fr;
#pragma unroll
        for (int ai = 0; ai < 2; ++ai)
#pragma unroll
            for (int m = 0; m < 4; ++m) pf[ai * 4 + m] = ld_f32_uncounted(gate + row0 + ai * 128 + m * 16); }
    DEVI void operator()(const f32x4 (&acc)[2][2][4][2], const Unit& u, int wr, int wc, int fr, int fq, const float (&pf)[8]) const {
        const int row0 = u.pm * 256 + wr * 64 + fr; bf16_t* base = Y + (size_t)row0 * D + u.pn * 256 + wc * 32 + 8 * fq;
#pragma unroll
        for (int ai = 0; ai < 2; ++ai)
#pragma unroll
            for (int m = 0; m < 4; ++m) { const float gv = pf[ai * 4 + m]; bf16_t* rp = base + (size_t)(ai * 128 + m * 16) * D;
#pragma unroll
                for (int bj = 0; bj < 2; ++bj) *(u32x4*)(rp + bj * 128) = pack8(acc[ai][bj][m][0] * gv, acc[ai][bj][m][1] * gv); } } };
DEVI float xsum_fq(float v) {
    { auto r = __builtin_amdgcn_permlane16_swap(__float_as_uint(v), __float_as_uint(v), false, false); v = __uint_as_float(r[0]) + __uint_as_float(r[1]); }
    { auto r = __builtin_amdgcn_permlane32_swap(__float_as_uint(v), __float_as_uint(v), false, false); v = __uint_as_float(r[0]) + __uint_as_float(r[1]); }
    return v; }
DEVI void row_pos(int row, bool& lat, int& b, int& pos, int& prow, int& pcol) { lat = row < RL; int tt; if (lat) { b = row >> 12; tt = row & 4095; pos = tt; } else { const int rc = row - RL; b = rc >> 8; tt = rc & 255; pos = T + tt; } prow = tt >> 6; pcol = tt & 63; }
DEVI void st4(bf16_t* p, const f32x4 v) { *(u32x2*)p = (u32x2){cvt_pk_bf16(v[0], v[1]), cvt_pk_bf16(v[2], v[3])}; }
struct EpiQKV0 { static constexpr bool HAS_PRE = false, PERM = false; bf16_t *Q, *K, *V; const float *qn, *kn, *rope; LAS float* xch;
    DEVI void operator()(const f32x4 (&acc)[2][2][4][2], const Unit& u, int wr, int wc, int fr, int fq) const {
        const int wave = wr * 4 + wc; const bool isv = u.pn == 5, isk = u.pn == 4;
        int frx = fr; asm volatile("" : "+v"(frx));
        float ps[2][4];
#pragma unroll
        for (int ai = 0; ai < 2; ++ai)
#pragma unroll
            for (int m = 0; m < 4; ++m) { float sq = 0.f;
#pragma unroll
                for (int bj = 0; bj < 2; ++bj)
#pragma unroll
                    for (int n = 0; n < 2; ++n) { const f32x4 v = acc[ai][bj][m][n]; sq += v[0] * v[0] + v[1] * v[1] + v[2] * v[2] + v[3] * v[3]; }
                ps[ai][m] = xsum_fq(sq); }
        if (fq == 0) {
#pragma unroll
            for (int ai = 0; ai < 2; ++ai)
#pragma unroll
                for (int m = 0; m < 4; ++m) xch[wave * 128 + ai * 64 + m * 16 + frx] = ps[ai][m]; }
        asm volatile("s_waitcnt lgkmcnt(0)" ::: "memory"); __builtin_amdgcn_s_barrier(); asm volatile("" ::: "memory");
#pragma unroll
        for (int ai = 0; ai < 2; ++ai)
#pragma unroll
            for (int m = 0; m < 4; ++m) ps[ai][m] = isv ? 1.f : rsqrtf((ps[ai][m] + xch[(wave ^ 1) * 128 + ai * 64 + m * 16 + frx]) * (1.f / 128.f) + 1e-6f);
        const int dlo = 32 * (wc & 1) + 4 * fq;
        f32x4 g[2][2];
#pragma unroll
        for (int bj = 0; bj < 2; ++bj)
#pragma unroll
            for (int n = 0; n < 2; ++n) g[bj][n] = isv ? (f32x4){1.f, 1.f, 1.f, 1.f} : *(const f32x4*)((isk ? kn : qn) + 64 * bj + dlo + 16 * n);
        const int hcol = (isk || isv ? (wc >> 1) : (2 * u.pn + (wc >> 1))) * 128 + dlo;
        const bool latT = u.pm * 256 < RL, colw = wc & 1;
#pragma unroll
        for (int mh = 0; mh < 2; ++mh) { f32x4 tab[2][2][2];
            if (latT && !isv) {
#pragma unroll
                for (int q = 0; q < 2; ++q) { const int tt0 = (u.pm * 256 + q * 128 + wr * 64) & 4095; const int pp = colw ? (16 * (2 * mh + q) + fr) : (tt0 >> 6); const float* rt = rope + (size_t)(pp * 32 + 4 * fq) * 2;
#pragma unroll
                    for (int n = 0; n < 2; ++n) { tab[q][n][0] = *(const f32x4*)(rt + 32 * n); tab[q][n][1] = *(const f32x4*)(rt + 32 * n + 4); } } }
#pragma unroll
            for (int ai = 0; ai < 2; ++ai)
#pragma unroll
                for (int mm = 0; mm < 2; ++mm) { const int m = 2 * mh + mm; const int row = u.pm * 256 + ai * 128 + wr * 64 + m * 16 + fr; bool lat; int b, pos, prow, pcol; row_pos(row, lat, b, pos, prow, pcol);
                    bf16_t* dst = Q + (size_t)row * D + hcol; unsigned char* d8 = (unsigned char*)(isk ? K : V) + ((size_t)b * KVLEN + pos) * 256 + hcol;
#pragma unroll
                    for (int n = 0; n < 2; ++n) { f32x4 x1 = acc[ai][0][m][n] * ps[ai][m] * g[0][n], x2 = acc[ai][1][m][n] * ps[ai][m] * g[1][n];
                        if (latT && !isv) { const f32x4 c0 = colw ? tab[mm][n][0] : tab[ai][n][0], c1 = colw ? tab[mm][n][1] : tab[ai][n][1];
                            const f32x4 cs = {c0[0], c0[2], c1[0], c1[2]}, sn = {c0[1], c0[3], c1[1], c1[3]}; const f32x4 y1 = x1 * cs - x2 * sn, y2 = x1 * sn + x2 * cs; x1 = y1; x2 = y2; }
                        if (isk || isv) { *(unsigned*)(d8 + 16 * n) = cvt4_fp8(x1[0], x1[1], x1[2], x1[3]); *(unsigned*)(d8 + 64 + 16 * n) = cvt4_fp8(x2[0], x2[1], x2[2], x2[3]); }
                        else { st4(dst + 16 * n, x1); st4(dst + 64 + 16 * n, x2); } } }
            __builtin_amdgcn_sched_barrier(0); }
    } };
struct EpiQKV1 { static constexpr bool HAS_PRE = false, PERM = false; bf16_t *Q, *K, *V; const float* rope;
    DEVI void operator()(const f32x4 (&acc)[2][2][4][2], const Unit& u, int wr, int wc, int fr, int fq) const {
        const bool isv = u.pn == 5, isk = u.pn == 4; const int hcol = (isk || isv ? wc : 4 * u.pn + wc) * 64 + 4 * fq;
        const bool latT = u.pm * 256 < RL; f32x4 tr[2][2], tc[4][2];
        if (latT && !isv) {
#pragma unroll
            for (int ai = 0; ai < 2; ++ai) { const int prow = ((u.pm * 256 + ai * 128 + wr * 64) & 4095) >> 6; const float* rt = rope + (size_t)(prow * 16 + 4 * fq) * 2; tr[ai][0] = *(const f32x4*)rt; tr[ai][1] = *(const f32x4*)(rt + 4); }
#pragma unroll
            for (int m = 0; m < 4; ++m) { const float* rt = rope + (size_t)((16 * m + fr) * 16 + 4 * fq) * 2; tc[m][0] = *(const f32x4*)rt; tc[m][1] = *(const f32x4*)(rt + 4); } }
#pragma unroll
        for (int ai = 0; ai < 2; ++ai)
#pragma unroll
            for (int m = 0; m < 4; ++m) { const int row = u.pm * 256 + ai * 128 + wr * 64 + m * 16 + fr; bool lat; int b, pos, prow, pcol; row_pos(row, lat, b, pos, prow, pcol);
                bf16_t* dst = Q + (size_t)row * D + hcol; unsigned char* d8 = (unsigned char*)(isk ? K : V) + ((size_t)b * KVLEN + pos) * 256 + hcol;
#pragma unroll
                for (int n = 0; n < 2; ++n) { f32x4 x1 = acc[ai][0][m][n], x2 = acc[ai][1][m][n];
                    if (latT && !isv) { const f32x4 c0 = n ? tc[m][0] : tr[ai][0], c1 = n ? tc[m][1] : tr[ai][1];
                        const f32x4 cs = {c0[0], c0[2], c1[0], c1[2]}, sn = {c0[1], c0[3], c1[1], c1[3]}; const f32x4 y1 = x1 * cs - x2 * sn, y2 = x1 * sn + x2 * cs; x1 = y1; x2 = y2; }
                    if (isk || isv) { *(unsigned*)(d8 + 16 * n) = cvt4_fp8(x1[0], x1[1], x1[2], x1[3]); *(unsigned*)(d8 + 32 + 16 * n) = cvt4_fp8(x2[0], x2[1], x2[2], x2[3]); }
                    else { st4(dst + 16 * n, x1); st4(dst + 32 + 16 * n, x2); } } }
    } };
struct G1Order { const char *A, *B, *BL; size_t sA; int nM;
    DEVI bool next(int i, Unit& u) const { const int n = 3 * nM * 4 + 3 * nM; const long L = (long)i * gridDim.x + BIDX; if (L >= n) return false;
        const int id = xcd_remap((int)L, n); int g, pm, pn; const char* b;
        if (id < 3 * nM * 4) { g = id / (nM * 4); const int rm = id % (nM * 4); pm = rm >> 2; pn = rm & 3; b = B + (size_t)g * 1024 * 1024 * 2 + (size_t)pn * 256 * 1024 * 2; }
        else { const int j = id - 3 * nM * 4; g = 3 + j / nM; pm = j % nM; pn = 0; b = BL + (size_t)(g - 3) * 256 * 1024 * 2; }
        u.e = g; u.pm = pm; u.pn = pn; u.gidx = nullptr; u.A = A + (size_t)g * sA + (size_t)pm * 256 * 1024 * 2; u.B = b; return true; }
};
struct EpiG1 { static constexpr bool HAS_PRE = false, PERM = true; bf16_t* RKV; size_t sC; bf16_t *L1WA, *L1G;
    DEVI void operator()(const f32x4 (&acc)[2][2][4][2], const Unit& u, int wr, int wc, int fr, int fq) const {
        const int row0 = u.pm * 256 + wr * 64 + fr, c0 = wc * 32 + 8 * fq;
        if (u.e < 3) { bf16_t* base = RKV + (size_t)u.e * sC + (size_t)row0 * D + u.pn * 256 + c0;
#pragma unroll
            for (int ai = 0; ai < 2; ++ai)
#pragma unroll
                for (int m = 0; m < 4; ++m) { bf16_t* rp = base + (size_t)(ai * 128 + m * 16) * D;
#pragma unroll
                    for (int bj = 0; bj < 2; ++bj) *(u32x4*)(rp + bj * 128) = pack8(acc[ai][bj][m][0], acc[ai][bj][m][1]); } }
        else { bf16_t* base = u.e == 5 ? L1G + (size_t)row0 * 128 + c0 : L1WA + (size_t)row0 * 256 + (u.e == 4 ? 128 : 0) + c0; const int ld = u.e == 5 ? 128 : 256;
#pragma unroll
            for (int ai = 0; ai < 2; ++ai)
#pragma unroll
                for (int m = 0; m < 4; ++m) { f32x4 v0 = acc[ai][0][m][0], v1 = acc[ai][0][m][1];
                    if (u.e == 3) {
#pragma unroll
                        for (int j = 0; j < 4; ++j) { v0[j] = tanhf_(v0[j]); v1[j] = tanhf_(v1[j]); } }
                    if (u.e == 5) {
#pragma unroll
                        for (int j = 0; j < 4; ++j) { v0[j] = sigmoidf_(v0[j]); v1[j] = sigmoidf_(v1[j]); } }
                    *(u32x4*)(base + (size_t)(ai * 128 + m * 16) * ld) = pack8(v0, v1); } }
    } };
struct EpiWA { static constexpr bool HAS_PRE = false, PERM = false; bf16_t* W; size_t sW; bf16_t* AB; const float *w0, *a0;
    template <bool DEC> DEVI void run(const f32x4 (&acc)[2][2][4][2], const float* bias, bf16_t* baseb) const {
        f32x4 bvv[2][2];
#pragma unroll
        for (int bj = 0; bj < 2; ++bj)
#pragma unroll
            for (int n = 0; n < 2; ++n) bvv[bj][n] = *(const f32x4*)(bias + bj * 128 + n * 16);
#pragma unroll
        for (int bj = 0; bj < 2; ++bj)
#pragma unroll
            for (int n = 0; n < 2; ++n) { const f32x4 bv = bvv[bj][n];
#pragma unroll
                for (int ai = 0; ai < 2; ++ai)
#pragma unroll
                    for (int m = 0; m < 4; ++m) { f32x4 v = acc[ai][bj][m][n] + bv;
#pragma unroll
                        for (int j = 0; j < 4; ++j) { const float sg = sigmoidf_(v[j]); v[j] = DEC ? 0.8750387749145276f * sg : sg; }
                        st4(baseb + (size_t)(ai * 128 + m * 16) * D + bj * 128 + n * 16, v);
                        __builtin_amdgcn_sched_barrier(0); } } }
    DEVI void operator()(const f32x4 (&acc)[2][2][4][2], const Unit& u, int wr, int wc, int fr, int fq) const {
        const int q = u.pn >> 2, lc0 = (u.pn & 3) * 256 + wc * 32 + 4 * fq; const size_t ro = (size_t)(u.pm * 256 + wr * 64 + fr) * D + lc0;
        if (q < 2) run<true>(acc, w0 + (q & 1) * 1024 + lc0, W + (size_t)q * sW + ro); else run<false>(acc, a0 + (q & 1) * 1024 + lc0, AB + (size_t)(q & 1) * sW + ro);
    } };
}
#define G8LDS ((LAS unsigned char*)(shm + 1024))

DEVI int wq_slot(int l) { return l == 0 ? 0 : (l == 1 ? 1 : 2); }
DEVI void ph_qkv_gemm(const P& p, int l) {
    g8::PlainOrder S{}; S.A = (const char*)WSP(bf16_t, WS_H); S.B = (const char*)(WSP(bf16_t, WS_WQKV) + (size_t)wq_slot(l) * 1536 * 1024); S.ng = 1; S.nM = R / 256; S.nN = 6; S.K = 512;
    if (l % 3 == 0) { g8::EpiQKV0 e{WSP(bf16_t, WS_QB), WSP(bf16_t, WS_KB), WSP(bf16_t, WS_VT), p.a_q_norm + (l / 3) * 128, p.a_k_norm + (l / 3) * 128, WSP(float, WS_ROPE), (LAS float*)(shm + 1024 + g8::STAGE_BYTES)}; g8::gemm_phase<g8::EpiQKV0, g8::PlainOrder, false, true>(G8LDS, 512, S, e, F1_SCALE); }
    else { g8::EpiQKV1 e{WSP(bf16_t, WS_QB), WSP(bf16_t, WS_KB), WSP(bf16_t, WS_VT), WSP(float, WS_ROPE) + 64 * 32 * 2}; g8::gemm_phase<g8::EpiQKV1, g8::PlainOrder, false, true>(G8LDS, 512, S, e, F1_SCALE); } }

DEVI void ph_qkv_post(const P& p, int l) {
    const int kind = l % 3, j = l / 3, lane = TIDX & 63, gw = BIDX * NWAVES + (TIDX >> 6), nw = gridDim.x * NWAVES;
    const float* qkv = WSP(float, WS_QKV); bf16_t* Qb = WSP(bf16_t, WS_QB); bf16_t* Kb = WSP(bf16_t, WS_KB); bf16_t* Vt = WSP(bf16_t, WS_VT);
    const float* rope = WSP(float, WS_ROPE) + (kind == 0 ? 0 : 64 * 32 * 2);
    for (int row = gw; row < R; row += nw) {
        const bool lat = row < RL; int b, pos, tt; if (lat) { b = row >> 12; tt = row & 4095; pos = tt; } else { const int rc = row - RL; b = rc >> 8; tt = rc & 255; pos = T + tt; }
        const int prow = tt >> 6, pcol = tt & 63;
        f32x4 vin[6];
#pragma unroll
        for (int ch = 0; ch < 6; ++ch) vin[ch] = *(const f32x4*)(qkv + (size_t)row * 1536 + ch * 256 + 4 * lane);
#pragma unroll
        for (int ch = 0; ch < 6; ++ch) {
            f32x4 v = vin[ch];
            if (ch < 5) {
                if (kind == 0) {
                    const float ss = sum32(v[0] * v[0] + v[1] * v[1] + v[2] * v[2] + v[3] * v[3]); const float ri = rsqrtf(ss * (1.f / 128.f) + 1e-6f);
                    const float* gn = (ch < 4 ? p.a_q_norm : p.a_k_norm) + j * 128 + 4 * (lane & 31);
                    v = v * ri * *(const f32x4*)gn;
                    if (lat) { f32x4 o; o[0] = __shfl_xor(v[0], 16); o[1] = __shfl_xor(v[1], 16); o[2] = __shfl_xor(v[2], 16); o[3] = __shfl_xor(v[3], 16);
                        const bool second = (lane & 16) != 0;
#pragma unroll
                        for (int q = 0; q < 4; ++q) { const int pi = 4 * (lane & 15) + q; const int pp = pi < 32 ? prow : pcol, f = pi & 31; const float cs = rope[(pp * 32 + f) * 2], sn = rope[(pp * 32 + f) * 2 + 1];
                            v[q] = second ? (o[q] * sn + v[q] * cs) : (v[q] * cs - o[q] * sn); } }
                } else {
                    if (lat) { f32x4 o; o[0] = __shfl_xor(v[0], 8); o[1] = __shfl_xor(v[1], 8); o[2] = __shfl_xor(v[2], 8); o[3] = __shfl_xor(v[3], 8);
                        const bool second = (lane & 8) != 0;
#pragma unroll
                        for (int q = 0; q < 4; ++q) { const int pi = 4 * (lane & 7) + q; const int pp = pi < 16 ? prow : pcol, f = pi & 15; const float cs = rope[(pp * 16 + f) * 2], sn = rope[(pp * 16 + f) * 2 + 1];
                            v[q] = second ? (o[q] * sn + v[q] * cs) : (v[q] * cs - o[q] * sn); } }
                }
                u32x2 w = {cvt_pk_bf16(v[0], v[1]), cvt_pk_bf16(v[2], v[3])};
                if (ch < 4) *(u32x2*)(Qb + (size_t)row * D + ch * 256 + 4 * lane) = w;
                else *(u32x2*)(Kb + ((size_t)b * KVLEN + pos) * 256 + 4 * lane) = w;
            } else {
                { u32x2 w = {cvt_pk_bf16(v[0], v[1]), cvt_pk_bf16(v[2], v[3])}; *(u32x2*)(Vt + ((size_t)b * KVLEN + pos) * 256 + 4 * lane) = w; }
            }
        }
    }
}

namespace a128 {
constexpr int DH = 128, QBLK = 32, KVBLK = 64, LDQ = 1024, LDK = 256, LDO = 1024;
constexpr float SCALE = 0.088388347648318440f, THR = 5.f;
constexpr size_t SHM_V = KVBLK * DH * 2, SHM_K = KVBLK * DH * 2, SHM_ATTN = 2 * SHM_V + 2 * SHM_K + NWAVES * 64 * 4;
#define KSWZ(row, colB) ((row) * 256 + ((colB) ^ (((row) & 7) << 4)))
#define SBAR() __builtin_amdgcn_sched_barrier(0)
DEVI void partialSM(f32x16& p0, f32x16& p1, float& m_reg, float& mn, float& alpha) {
  constexpr float C = SCALE * 1.4426950408889634f;
  float pmax = p0[0]; for (int r = 1; r < 16; ++r) pmax = fmaxf(pmax, p0[r]); for (int r = 0; r < 16; ++r) pmax = fmaxf(pmax, p1[r]);
  { auto rr = __builtin_amdgcn_permlane32_swap(__float_as_uint(pmax), __float_as_uint(pmax), false, false);
    pmax = fmaxf(__uint_as_float(rr[0]), __uint_as_float(rr[1])); }
  if (__builtin_expect(__all(pmax - m_reg <= THR / SCALE), 1)) { mn = m_reg; alpha = 1.f; }
  else { mn = fmaxf(m_reg, pmax); alpha = __builtin_amdgcn_exp2f((m_reg - mn) * C); m_reg = mn; }
  float mnC = 1.f - mn * C;
  for (int r = 0; r < 16; ++r) p0[r] = fmaf(p0[r], C, mnC); for (int r = 0; r < 16; ++r) p1[r] = fmaf(p1[r], C, mnC);
  for (int r = 0; r < 16; ++r) p0[r] = __builtin_amdgcn_exp2f(p0[r]);
}
DEVI void finishSM(f32x16& p0, f32x16& p1, float alpha, float& l_reg, bf16x8& pa0, bf16x8& pa1, bf16x8& pa2, bf16x8& pa3) {
  for (int r = 0; r < 16; ++r) p1[r] = __builtin_amdgcn_exp2f(p1[r]);
  float ps = 0; for (int r = 0; r < 16; ++r) ps += p0[r]; for (int r = 0; r < 16; ++r) ps += p1[r];
  { auto rr = __builtin_amdgcn_permlane32_swap(__float_as_uint(ps), __float_as_uint(ps), false, false);
    ps = __uint_as_float(rr[0]) + __uint_as_float(rr[1]); }
  l_reg = l_reg * alpha + ps;
#define PK4(Pv, BASE, OUT) do { unsigned a0 = cvt_pk_bf16_asm(Pv[BASE + 0], Pv[BASE + 1]), a1 = cvt_pk_bf16_asm(Pv[BASE + 2], Pv[BASE + 3]);   \
    unsigned b0 = cvt_pk_bf16_asm(Pv[BASE + 4], Pv[BASE + 5]), b1 = cvt_pk_bf16_asm(Pv[BASE + 6], Pv[BASE + 7]);                              \
    auto r0 = __builtin_amdgcn_permlane32_swap(a0, b0, false, false); auto r1 = __builtin_amdgcn_permlane32_swap(a1, b1, false, false); \
    u32x4 w = {r0[0], r1[0], r0[1], r1[1]}; OUT = *reinterpret_cast<bf16x8*>(&w); } while (0)
  PK4(p0, 0, pa0); PK4(p0, 8, pa1); PK4(p1, 0, pa2); PK4(p1, 8, pa3);
#undef PK4
}
#define KSWZ8(row, colB) ((row) * 128 + ((colB) ^ ((((row) >> 1) & 7) << 4)))
DEVI void qkt(f32x16& p0, f32x16& p1, const char* Ks, const i32x8* q8, int r32, int hi) {
  p0 = f32x16{}; p1 = f32x16{};
#pragma unroll
  for (int s = 0; s < 2; ++s) { const int cb = 64 * s + 32 * hi;
    const i32x4 a0 = *reinterpret_cast<const i32x4*>(Ks + KSWZ8(r32, cb)), a1 = *reinterpret_cast<const i32x4*>(Ks + KSWZ8(r32, cb + 16));
    const i32x4 b0 = *reinterpret_cast<const i32x4*>(Ks + KSWZ8(32 + r32, cb)), b1 = *reinterpret_cast<const i32x4*>(Ks + KSWZ8(32 + r32, cb + 16));
    p0 = __builtin_amdgcn_mfma_scale_f32_32x32x64_f8f6f4(__builtin_shufflevector(a0, a1, 0, 1, 2, 3, 4, 5, 6, 7), q8[s], p0, 0, 0, 0, 0x7F7F7F7F, 0, 0x7F7F7F7F);
    p1 = __builtin_amdgcn_mfma_scale_f32_32x32x64_f8f6f4(__builtin_shufflevector(b0, b1, 0, 1, 2, 3, 4, 5, 6, 7), q8[s], p1, 0, 0, 0, 0x7F7F7F7F, 0, 0x7F7F7F7F); }
}
DEVI u32x2 k8pack(const bf16x8 v) { const u32x4 w = __builtin_bit_cast(u32x4, v); return (u32x2){cvt4_fp8(bflo(w[0]), bfhi(w[0]), bflo(w[1]), bfhi(w[1])), cvt4_fp8(bflo(w[2]), bfhi(w[2]), bflo(w[3]), bfhi(w[3]))}; }
DEVI int v_st(int k, int c) { const int kk = (k & ~0xC) | ((k & 4) << 1) | ((k & 8) >> 1); return ((kk >> 3) * 4 + (c >> 5)) * 512 + ((kk & 7) * 32 + (c & 31)) * 2; }
DEVI int v_rd_base(int lane) { return ((lane & 3) << 3) | (((lane >> 2) & 3) << 6) | (((lane >> 4) & 1) << 5) | (((lane >> 5) & 1) << 8); }
constexpr int v_rd_off(int d0, int ks, int half) { return d0 * 512 + ks * 4096 + half * 2048; }
template <int OFF> DEVI s16x4 tr_read(int vb) { s16x4 r; asm volatile("ds_read_b64_tr_b16 %0, %1 offset:%2" : "=&v"(r) : "v"(vb), "i"(OFF) : "memory"); return r; }
template <int D0> DEVI void pv_one(f32x16& od, int vb, bf16x8 pa0, bf16x8 pa1, bf16x8 pa2, bf16x8 pa3) {
  const s16x4 l0 = tr_read<v_rd_off(D0, 0, 0)>(vb), h0 = tr_read<v_rd_off(D0, 0, 1)>(vb), l1 = tr_read<v_rd_off(D0, 1, 0)>(vb), h1 = tr_read<v_rd_off(D0, 1, 1)>(vb);
  const s16x4 l2 = tr_read<v_rd_off(D0, 2, 0)>(vb), h2 = tr_read<v_rd_off(D0, 2, 1)>(vb), l3 = tr_read<v_rd_off(D0, 3, 0)>(vb), h3 = tr_read<v_rd_off(D0, 3, 1)>(vb);
  asm volatile("s_waitcnt lgkmcnt(0)" ::: "memory"); SBAR();
#define PK(L, H) (bf16x8){L[0], L[1], L[2], L[3], H[0], H[1], H[2], H[3]}
  od = __builtin_amdgcn_mfma_f32_32x32x16_bf16(pa0, PK(l0, h0), od, 0, 0, 0);
  od = __builtin_amdgcn_mfma_f32_32x32x16_bf16(pa1, PK(l1, h1), od, 0, 0, 0);
  od = __builtin_amdgcn_mfma_f32_32x32x16_bf16(pa2, PK(l2, h2), od, 0, 0, 0);
  od = __builtin_amdgcn_mfma_f32_32x32x16_bf16(pa3, PK(l3, h3), od, 0, 0, 0);
#undef PK
}
DEVI void pv_d0(f32x16* o, int vb, bf16x8 pa0, bf16x8 pa1, bf16x8 pa2, bf16x8 pa3) {
  pv_one<0>(o[0], vb, pa0, pa1, pa2, pa3); pv_one<1>(o[1], vb, pa0, pa1, pa2, pa3); pv_one<2>(o[2], vb, pa0, pa1, pa2, pa3); pv_one<3>(o[3], vb, pa0, pa1, pa2, pa3);
}
DEVI unsigned p4(const f32x16& p, int b) { int w = 0; w = __builtin_amdgcn_cvt_pk_fp8_f32(p[b], p[b + 1], w, false); w = __builtin_amdgcn_cvt_pk_fp8_f32(p[b + 2], p[b + 3], w, true); return (unsigned)w; }
DEVI void finishSM8(f32x16& p0, f32x16& p1, float alpha, float& l_reg, i32x8& pa) {
  for (int r = 0; r < 16; ++r) p1[r] = __builtin_amdgcn_exp2f(p1[r]);
  (void)alpha; (void)l_reg;
  const auto r0 = __builtin_amdgcn_permlane32_swap(p4(p0, 0), p4(p0, 8), false, false), t0 = __builtin_amdgcn_permlane32_swap(p4(p0, 4), p4(p0, 12), false, false);
  const auto r1 = __builtin_amdgcn_permlane32_swap(p4(p1, 0), p4(p1, 8), false, false), t1 = __builtin_amdgcn_permlane32_swap(p4(p1, 4), p4(p1, 12), false, false);
  pa = (i32x8){(int)r0[0], (int)r0[1], (int)t0[0], (int)t0[1], (int)r1[0], (int)r1[1], (int)t1[0], (int)t1[1]};
}
template <int D0> DEVI void pv_one8(f32x16& od, int vb, const i32x8 pa) {
  const s16x4 l0 = tr_read<v_rd_off(D0, 0, 0)>(vb), h0 = tr_read<v_rd_off(D0, 0, 1)>(vb), l1 = tr_read<v_rd_off(D0, 1, 0)>(vb), h1 = tr_read<v_rd_off(D0, 1, 1)>(vb);
  asm volatile("s_waitcnt lgkmcnt(0)" ::: "memory"); SBAR();
  typedef int i32x2_ __attribute__((ext_vector_type(2)));
  const i32x2_ a = __builtin_bit_cast(i32x2_, l0), b = __builtin_bit_cast(i32x2_, h0), c = __builtin_bit_cast(i32x2_, l1), d = __builtin_bit_cast(i32x2_, h1);
  od = __builtin_amdgcn_mfma_scale_f32_32x32x64_f8f6f4(pa, (i32x8){a[0], a[1], b[0], b[1], c[0], c[1], d[0], d[1]}, od, 0, 0, 0, 0x7F7F7F7F, 0, 0x7F7F7F7F);
}
DEVI void pv_d08(f32x16* o, f32x16& ls, int vb, const i32x8 pa) { pv_one8<0>(o[0], vb, pa); pv_one8<1>(o[1], vb, pa); pv_one8<2>(o[2], vb, pa); pv_one8<3>(o[3], vb, pa);
  const int one4 = 0x38383838; ls = __builtin_amdgcn_mfma_scale_f32_32x32x64_f8f6f4(pa, (i32x8){one4, one4, one4, one4, one4, one4, one4, one4}, ls, 0, 0, 0, 0x7F7F7F7F, 0, 0x7F7F7F7F); }
DEVI u32x2 k8raw(const bf16x8 v) { const u32x4 w = __builtin_bit_cast(u32x4, v); int x = 0, y = 0;
  x = __builtin_amdgcn_cvt_pk_fp8_f32(bflo(w[0]), bfhi(w[0]), x, false); x = __builtin_amdgcn_cvt_pk_fp8_f32(bflo(w[1]), bfhi(w[1]), x, true);
  y = __builtin_amdgcn_cvt_pk_fp8_f32(bflo(w[2]), bfhi(w[2]), y, false); y = __builtin_amdgcn_cvt_pk_fp8_f32(bflo(w[3]), bfhi(w[3]), y, true); return (u32x2){(unsigned)x, (unsigned)y}; }
DEVI void body(const bf16_t* __restrict__ Qb, const unsigned char* __restrict__ Kh, const unsigned char* __restrict__ Vh, bf16_t* __restrict__ Ob, int seq, LAS char* ldsl) {
  const int tid = TIDX, wid = tid >> 6, lane = tid & 63, r32 = lane & 31, hi = lane >> 5;
  char* lds = (char*)ldsl;
  char* V_lds = lds; char* K_lds = lds + 2 * SHM_V;
  float* ws = (float*)(lds + 2 * SHM_V + 2 * SHM_K) + wid * 64; float* li_l = ws; float* al_l = ws + 32;
  float m_reg = -1e30f, l_reg = 0; f32x16 o[4] = {}; f32x16 ls = {}; i32x8 qr[2];
  const bf16_t* Qw = Qb + (long)(wid * QBLK + r32) * LDQ + hi * 32;
#pragma unroll
  for (int s = 0; s < 2; ++s) { bf16x8 qv[4];
#pragma unroll
    for (int c = 0; c < 4; ++c) qv[c] = *(const bf16x8*)(Qw + s * 64 + c * 8);
    const u32x2 c0 = k8pack(qv[0]), c1 = k8pack(qv[1]), c2 = k8pack(qv[2]), c3 = k8pack(qv[3]);
    qr[s] = (i32x8){(int)c0[0], (int)c0[1], (int)c1[0], (int)c1[1], (int)c2[0], (int)c2[1], (int)c3[0], (int)c3[1]}; }
  const int sr = tid >> 4, sc = (tid & 15) * 8, vst0 = v_st(sr, sc), vst1 = v_st(32 + sr, sc);
  const int vb0 = (int)(uintptr_t)ldsl + v_rd_base(lane);
  struct { u32x2 vs0, vs1, ks0, ks1; } sr_[2];
  const unsigned loff0 = (unsigned)(sr * LDK + sc), loff1 = loff0 + 32u * LDK, lvf0 = (unsigned)(2 * sr * LDK + sc), lvf1 = lvf0 + LDK;
#define SLOAD(i, k0) do { const char* _vb = (const char*)Vh + (size_t)(k0) * LDK; const char* _kb = (const char*)Kh + (size_t)(k0) * LDK; \
    sr_[i].vs0 = *(const u32x2*)(_vb + lvf0); sr_[i].vs1 = *(const u32x2*)(_vb + lvf1); sr_[i].ks0 = *(const u32x2*)(_kb + loff0); sr_[i].ks1 = *(const u32x2*)(_kb + loff1); } while (0)
#define SWRITE(b, i) do { const u32x2 _e = sr_[i].vs0, _o = sr_[i].vs1;    \
    *(u32x4*)(V_lds + (b) * SHM_V + vst0) = (u32x4){__builtin_amdgcn_perm(_o[0], _e[0], 0x05010400u), __builtin_amdgcn_perm(_o[0], _e[0], 0x07030602u), __builtin_amdgcn_perm(_o[1], _e[1], 0x05010400u), __builtin_amdgcn_perm(_o[1], _e[1], 0x07030602u)}; \
    *(u32x2*)(K_lds + (b) * SHM_K + KSWZ8(sr, sc)) = sr_[i].ks0;                \
    *(u32x2*)(K_lds + (b) * SHM_K + KSWZ8(32 + sr, sc)) = sr_[i].ks1; } while (0)
#define SWAIT() asm volatile("s_waitcnt vmcnt(4)" ::: "memory")
#define RESC(a) do { if (__any((a) < 1.f)) { if (hi == 0) al_l[r32] = (a); asm volatile("s_waitcnt lgkmcnt(0)" ::: "memory"); \
    for (int r = 0; r < 16; ++r) { const float _al = al_l[crow(r, hi)]; ls[r] *= _al; for (int d = 0; d < 4; ++d) o[d][r] *= _al; } } } while (0)
  f32x16 pA0, pA1, pB0, pB1; float mnA, mnB, alA, alB; i32x8 pa8; const int NT = seq / KVBLK;
  constexpr int SE = 0, SO = 1;
  SLOAD(SE, 0); asm volatile("s_waitcnt vmcnt(0)" ::: "memory"); SWRITE(0, SE); __syncthreads();
  qkt(pA0, pA1, K_lds, qr, r32, hi); partialSM(pA0, pA1, m_reg, mnA, alA);
  SLOAD(SO, KVBLK); if (2 < NT) SLOAD(SE, 2 * KVBLK);
  SWAIT(); SWRITE(1, SO); __syncthreads();
  for (int j = 1; j + 1 < NT; j += 2) {
    SBAR(); qkt(pB0, pB1, K_lds + SHM_K, qr, r32, hi);
    finishSM8(pA0, pA1, alA, l_reg, pa8); SBAR();
    SLOAD(SO, (j + 2) * KVBLK); SBAR();
    pv_d08(o, ls, vb0, pa8); partialSM(pB0, pB1, m_reg, mnB, alB);
    __syncthreads(); SWAIT(); SWRITE(0, SE);
    RESC(alB); __syncthreads();
    SBAR(); qkt(pA0, pA1, K_lds, qr, r32, hi);
    finishSM8(pB0, pB1, alB, l_reg, pa8); SBAR();
    if (j + 3 < NT) SLOAD(SE, (j + 3) * KVBLK); SBAR();
    pv_d08(o, ls, vb0 + (int)SHM_V, pa8); partialSM(pA0, pA1, m_reg, mnA, alA);
    __syncthreads(); SWAIT(); SWRITE(1, SO);
    RESC(alA); __syncthreads();
  }
  SBAR(); qkt(pB0, pB1, K_lds + SHM_K, qr, r32, hi);
  finishSM8(pA0, pA1, alA, l_reg, pa8); SBAR();
  pv_d08(o, ls, vb0, pa8); partialSM(pB0, pB1, m_reg, mnB, alB);
  __syncthreads(); RESC(alB);
  finishSM8(pB0, pB1, alB, l_reg, pa8); SBAR();
  pv_d08(o, ls, vb0 + (int)SHM_V, pa8);
  float rli[16];
#pragma unroll
  for (int r = 0; r < 16; ++r) rli[r] = __builtin_amdgcn_rcpf(ls[r]);
  bf16_t* Ow = Ob + (long)(wid * QBLK) * LDO;
#pragma unroll
  for (int r = 0; r < 16; ++r) { int orow = crow(r, hi);
    for (int d0 = 0; d0 < 4; ++d0) Ow[(long)orow * LDO + d0 * 32 + r32] = f2bf(o[d0][r] * rli[r]); }
#undef SLOAD
#undef SWRITE
#undef SWAIT
#undef RESC
}
}
namespace a64 {
constexpr int DH = 64, QBLK = 32, KVBLK = 64, LDQ = 1024, LDK = 256, LDO = 1024;
constexpr float SCALE = 0.125f, THR = 5.f;
constexpr size_t SHM_V = KVBLK * DH * 2, SHM_K = KVBLK * DH * 2;
#define KSWZ64(row, colB) ((row) * 128 + ((colB) ^ (((row) & 7) << 4)))
DEVI void partialSM(f32x16& p0, f32x16& p1, float& m_reg, float& mn, float& alpha, bool masked, int dq0  ) {
  constexpr float C = SCALE * 1.4426950408889634f;
  if (masked) {
    for (int r = 0; r < 16; ++r) { const int dq = dq0 + (r & 3) + 8 * (r >> 2); if (dq > 128 || dq < -128) p0[r] = -1e30f; const int d2 = dq + 32; if (d2 > 128 || d2 < -128) p1[r] = -1e30f; } }
  float pmax = p0[0]; for (int r = 1; r < 16; ++r) pmax = fmaxf(pmax, p0[r]); for (int r = 0; r < 16; ++r) pmax = fmaxf(pmax, p1[r]);
  { auto rr = __builtin_amdgcn_permlane32_swap(__float_as_uint(pmax), __float_as_uint(pmax), false, false);
    pmax = fmaxf(__uint_as_float(rr[0]), __uint_as_float(rr[1])); }
  if (__builtin_expect(__all(pmax - m_reg <= THR / SCALE), 1)) { mn = m_reg; alpha = 1.f; }
  else { mn = fmaxf(m_reg, pmax); alpha = __builtin_amdgcn_exp2f((m_reg - mn) * C); m_reg = mn; }
  float mnC = 1.f - mn * C;
  for (int r = 0; r < 16; ++r) p0[r] = fmaf(p0[r], C, mnC); for (int r = 0; r < 16; ++r) p1[r] = fmaf(p1[r], C, mnC);
  for (int r = 0; r < 16; ++r) p0[r] = __builtin_amdgcn_exp2f(p0[r]);
}
#define KSWZ4(row, colB) ((row) * 64 + ((colB) ^ ((((row) >> 2) & 3) << 4)))
DEVI void qkt(f32x16& p0, f32x16& p1, const char* Ks, const i32x8 q8, int r32, int hi) {
  const int cb = 32 * hi; const f32x16 z = {};
  const i32x4 a0 = *reinterpret_cast<const i32x4*>(Ks + KSWZ4(r32, cb)), a1 = *reinterpret_cast<const i32x4*>(Ks + KSWZ4(r32, cb + 16));
  const i32x4 b0 = *reinterpret_cast<const i32x4*>(Ks + KSWZ4(32 + r32, cb)), b1 = *reinterpret_cast<const i32x4*>(Ks + KSWZ4(32 + r32, cb + 16));
  p0 = __builtin_amdgcn_mfma_scale_f32_32x32x64_f8f6f4(__builtin_shufflevector(a0, a1, 0, 1, 2, 3, 4, 5, 6, 7), q8, z, 0, 0, 0, 0x7F7F7F7F, 0, 0x7F7F7F7F);
  p1 = __builtin_amdgcn_mfma_scale_f32_32x32x64_f8f6f4(__builtin_shufflevector(b0, b1, 0, 1, 2, 3, 4, 5, 6, 7), q8, z, 0, 0, 0, 0x7F7F7F7F, 0, 0x7F7F7F7F);
}
DEVI int v_st(int k, int c) { const int kk = (k & ~0xC) | ((k & 4) << 1) | ((k & 8) >> 1); return ((kk >> 3) * 2 + (c >> 5)) * 512 + ((kk & 7) * 32 + (c & 31)) * 2; }
constexpr int v_rd_off(int d0, int ks, int half) { return d0 * 512 + ks * 2048 + half * 1024; }
template <int D0> DEVI void pv_one(f32x16& od, int vb, bf16x8 pa0, bf16x8 pa1, bf16x8 pa2, bf16x8 pa3) {
  using a128::tr_read;
  const s16x4 l0 = tr_read<v_rd_off(D0, 0, 0)>(vb), h0 = tr_read<v_rd_off(D0, 0, 1)>(vb), l1 = tr_read<v_rd_off(D0, 1, 0)>(vb), h1 = tr_read<v_rd_off(D0, 1, 1)>(vb);
  const s16x4 l2 = tr_read<v_rd_off(D0, 2, 0)>(vb), h2 = tr_read<v_rd_off(D0, 2, 1)>(vb), l3 = tr_read<v_rd_off(D0, 3, 0)>(vb), h3 = tr_read<v_rd_off(D0, 3, 1)>(vb);
  asm volatile("s_waitcnt lgkmcnt(0)" ::: "memory"); SBAR();
#define PK(L, H) (bf16x8){L[0], L[1], L[2], L[3], H[0], H[1], H[2], H[3]}
  od = __builtin_amdgcn_mfma_f32_32x32x16_bf16(pa0, PK(l0, h0), od, 0, 0, 0);
  od = __builtin_amdgcn_mfma_f32_32x32x16_bf16(pa1, PK(l1, h1), od, 0, 0, 0);
  od = __builtin_amdgcn_mfma_f32_32x32x16_bf16(pa2, PK(l2, h2), od, 0, 0, 0);
  od = __builtin_amdgcn_mfma_f32_32x32x16_bf16(pa3, PK(l3, h3), od, 0, 0, 0);
#undef PK
}
DEVI void pv_d0(f32x16* o, int vb, bf16x8 pa0, bf16x8 pa1, bf16x8 pa2, bf16x8 pa3) { pv_one<0>(o[0], vb, pa0, pa1, pa2, pa3); pv_one<1>(o[1], vb, pa0, pa1, pa2, pa3); }
template <int D0> DEVI i32x8 v_frag8(int vb) { using a128::tr_read;
  const s16x4 l0 = tr_read<v_rd_off(D0, 0, 0)>(vb), h0 = tr_read<v_rd_off(D0, 0, 1)>(vb), l1 = tr_read<v_rd_off(D0, 1, 0)>(vb), h1 = tr_read<v_rd_off(D0, 1, 1)>(vb);
  typedef int i32x2_ __attribute__((ext_vector_type(2)));
  const i32x2_ a = __builtin_bit_cast(i32x2_, l0), b = __builtin_bit_cast(i32x2_, h0), c = __builtin_bit_cast(i32x2_, l1), d = __builtin_bit_cast(i32x2_, h1);
  return (i32x8){a[0], a[1], b[0], b[1], c[0], c[1], d[0], d[1]}; }
DEVI void pv_d08(f32x16* o, f32x16& ls, int vb, const i32x8 pa) {
  const i32x8 f0 = v_frag8<0>(vb), f1 = v_frag8<1>(vb);
  const int one4 = 0x38383838; ls = __builtin_amdgcn_mfma_scale_f32_32x32x64_f8f6f4(pa, (i32x8){one4, one4, one4, one4, one4, one4, one4, one4}, ls, 0, 0, 0, 0x7F7F7F7F, 0, 0x7F7F7F7F);
  asm volatile("s_waitcnt lgkmcnt(0)" ::: "memory"); SBAR();
  o[0] = __builtin_amdgcn_mfma_scale_f32_32x32x64_f8f6f4(pa, f0, o[0], 0, 0, 0, 0x7F7F7F7F, 0, 0x7F7F7F7F);
  o[1] = __builtin_amdgcn_mfma_scale_f32_32x32x64_f8f6f4(pa, f1, o[1], 0, 0, 0, 0x7F7F7F7F, 0, 0x7F7F7F7F);
}
DEVI void body(const bf16_t* __restrict__ Qb, const unsigned char* __restrict__ Kh, const unsigned char* __restrict__ Vh, bf16_t* __restrict__ Ob, int qpos0, int wstart, int nwin, float sink, LAS char* ldsl) {
  using a128::finishSM8;
  const int tid = TIDX, wid = tid >> 6, lane = tid & 63, r32 = lane & 31, hi = lane >> 5;
  char* lds = (char*)ldsl;
  char* V_lds = lds; char* K_lds = lds + 2 * SHM_V;
  float* ws = (float*)(lds + 2 * SHM_V + 2 * SHM_K) + wid * 64; float* li_l = ws; float* al_l = ws + 32;
  float m_reg = sink * (1.f / SCALE), l_reg = 1.f; f32x16 o[2] = {}; f32x16 ls; i32x8 qr;
#pragma unroll
  for (int r = 0; r < 16; ++r) ls[r] = 2.f;
  { const bf16_t* Qw = Qb + (long)(wid * QBLK + r32) * LDQ + hi * 32; bf16x8 qv[4];
#pragma unroll
    for (int c = 0; c < 4; ++c) qv[c] = *(const bf16x8*)(Qw + c * 8);
    const u32x2 c0 = a128::k8pack(qv[0]), c1 = a128::k8pack(qv[1]), c2 = a128::k8pack(qv[2]), c3 = a128::k8pack(qv[3]);
    qr = (i32x8){(int)c0[0], (int)c0[1], (int)c1[0], (int)c1[1], (int)c2[0], (int)c2[1], (int)c3[0], (int)c3[1]}; }
  const int sr = tid >> 3, sc = (tid & 7) * 8, va = tid >> 4, vc = (tid & 15) * 4, vst0 = v_st(va, vc);
  const int vb0 = (int)(uintptr_t)ldsl + a128::v_rd_base(lane);
  const int qpos = qpos0 + wid * QBLK + r32;
  struct { unsigned ve, vo; u32x2 ks0; } sr_[2];
#define KSTART(j) ((j) < nwin ? wstart + (j) * KVBLK : T + ((j) - nwin) * KVBLK)
  const unsigned loff0 = (unsigned)(sr * LDK + sc), lvf0 = (unsigned)(2 * va * LDK + vc);
#define SLOAD(i, j) do { const size_t _k = (size_t)KSTART(j) * LDK; sr_[i].ve = *(const unsigned*)((const char*)Vh + _k + lvf0); sr_[i].vo = *(const unsigned*)((const char*)Vh + _k + lvf0 + LDK); sr_[i].ks0 = *(const u32x2*)((const char*)Kh + _k + loff0); } while (0)
#define SWRITE(b, i) do { *(u32x2*)(V_lds + (b) * SHM_V + vst0) = (u32x2){__builtin_amdgcn_perm(sr_[i].vo, sr_[i].ve, 0x05010400u), __builtin_amdgcn_perm(sr_[i].vo, sr_[i].ve, 0x07030602u)}; \
    *(u32x2*)(K_lds + (b) * SHM_K + KSWZ4(sr, sc)) = sr_[i].ks0; } while (0)
#define SWAIT() asm volatile("s_waitcnt vmcnt(3)" ::: "memory")
#define RESC(a) do { if (__any((a) < 1.f)) { if (hi == 0) al_l[r32] = (a); asm volatile("s_waitcnt lgkmcnt(0)" ::: "memory"); \
    for (int r = 0; r < 16; ++r) { const float _al = al_l[crow(r, hi)]; ls[r] *= _al; o[0][r] *= _al; o[1][r] *= _al; } } } while (0)
#define PSM(P0, P1, MN, AL, j) partialSM(P0, P1, m_reg, MN, AL, (j) < nwin, KSTART(j) + 4 * hi - qpos)
  f32x16 pA0, pA1, pB0, pB1; float mnA, mnB, alA, alB; i32x8 pa8; const int NT = nwin + 4;
  constexpr int SE = 0, SO = 1;
  SLOAD(SE, 0); asm volatile("s_waitcnt vmcnt(0)" ::: "memory"); SWRITE(0, SE); __syncthreads();
  qkt(pA0, pA1, K_lds, qr, r32, hi); PSM(pA0, pA1, mnA, alA, 0);
  SLOAD(SO, 1); if (2 < NT) SLOAD(SE, 2);
  SWAIT(); SWRITE(1, SO); __syncthreads();
  for (int j = 1; j + 1 < NT; j += 2) {
    SBAR(); qkt(pB0, pB1, K_lds + SHM_K, qr, r32, hi);
    finishSM8(pA0, pA1, alA, l_reg, pa8); SBAR();
    SLOAD(SO, j + 2); SBAR();
    pv_d08(o, ls, vb0, pa8); PSM(pB0, pB1, mnB, alB, j);
    __syncthreads(); SWAIT(); SWRITE(0, SE);
    RESC(alB); __syncthreads();
    SBAR(); qkt(pA0, pA1, K_lds, qr, r32, hi);
    finishSM8(pB0, pB1, alB, l_reg, pa8); SBAR();
    if (j + 3 < NT) SLOAD(SE, j + 3); SBAR();
    pv_d08(o, ls, vb0 + (int)SHM_V, pa8); PSM(pA0, pA1, mnA, alA, j + 1);
    __syncthreads(); SWAIT(); SWRITE(1, SO);
    RESC(alA); __syncthreads();
  }
  SBAR(); qkt(pB0, pB1, K_lds + SHM_K, qr, r32, hi);
  finishSM8(pA0, pA1, alA, l_reg, pa8); SBAR();
  pv_d08(o, ls, vb0, pa8); PSM(pB0, pB1, mnB, alB, NT - 1);
  __syncthreads(); RESC(alB);
  finishSM8(pB0, pB1, alB, l_reg, pa8); SBAR();
  pv_d08(o, ls, vb0 + (int)SHM_V, pa8);
  float rli[16];
#pragma unroll
  for (int r = 0; r < 16; ++r) rli[r] = __builtin_amdgcn_rcpf(ls[r]);
  bf16_t* Ow = Ob + (long)(wid * QBLK) * LDO;
#pragma unroll
  for (int r = 0; r < 16; ++r) { int orow = crow(r, hi);
    for (int d0 = 0; d0 < 2; ++d0) Ow[(long)orow * LDO + d0 * 32 + r32] = f2bf(o[d0][r] * rli[r]); }
#undef KSTART
#undef SLOAD
#undef SWRITE
#undef SWAIT
#undef RESC
#undef PSM
}
}
DEVI void deal_kv(int u, int nkv, int& b, int& h, int& qb) {
    if (gridDim.x == 256) { const int r = u >> 8, c = u & 255, x = c & 7, li = c >> 3, ui = (x & 1) * 32 + li, G = r * 4 + (x >> 1); b = G / nkv; h = (G % nkv) * 4 + (ui >> 4); qb = ui & 15; }
    else { qb = u % 16; h = (u / 16) % (4 * nkv); b = u / (64 * nkv); }
}
DEVI void ph_attn_b(const P& p, int l) {
    const bf16_t* Qb = WSP(bf16_t, WS_QB); const bf16_t* Kb = WSP(bf16_t, WS_KB); const bf16_t* Vb = WSP(bf16_t, WS_VT); bf16_t* Ob = WSP(bf16_t, WS_O);
    const int nlat = NB * 16 * (T / 256), nctx = (l == DEPTH - 1) ? 0 : NB * 16;
    for (int u = BIDX; u < nlat + nctx; u += gridDim.x) {
        __syncthreads();
        if (u < nlat) { int qb, h, b; deal_kv(u, 4, b, h, qb); const int q0p = qb * 256; const size_t q0 = ((size_t)b * T + q0p) * D + h * 64, k0 = (size_t)b * KVLEN * 256 + (h >> 2) * 64;
            const int ws = q0p - 128 < 0 ? 0 : q0p - 128, we = q0p + 384 > T ? T : q0p + 384;
            a64::body(Qb + q0, (const unsigned char*)Kb + k0, (const unsigned char*)Vb + k0, Ob + q0, q0p, ws, (we - ws) / 64, p.b_sink[(l / 3) * 16 + h], (LAS char*)(shm + 1024)); }
        else { const int v = u - nlat, h = v % 16, b = v / 16; const size_t q0 = ((size_t)RL + b * CL) * D + h * 64, k0 = (size_t)b * KVLEN * 256 + (h >> 2) * 64;
            a64::body(Qb + q0, (const unsigned char*)Kb + k0, (const unsigned char*)Vb + k0, Ob + q0, -1000000, 0, 0, p.b_sink[(l / 3) * 16 + h], (LAS char*)(shm + 1024)); }
    }
}

DEVI void ph_attn_a(const P& p, int l) {
    const bf16_t* Qb = WSP(bf16_t, WS_QB); const bf16_t* Kb = WSP(bf16_t, WS_KB); const bf16_t* Vb = WSP(bf16_t, WS_VT); bf16_t* Ob = WSP(bf16_t, WS_O);
    const int nlat = NB * 8 * (T / 256), nctx = (l == DEPTH - 1) ? 0 : NB * 8;
    for (int u = BIDX; u < nlat + nctx; u += gridDim.x) {
        __syncthreads();
        const bool isl = u < nlat; const int v = isl ? u : u - nlat; int h = v % 8, b = v / 8, qb = 0; if (isl) deal_kv(u, 2, b, h, qb);
        const size_t q0 = (isl ? (size_t)b * T + qb * 256 : (size_t)RL + b * CL) * D + h * 128, k0 = ((size_t)b * KVLEN + (isl ? 0 : T)) * 256 + (h >> 2) * 128;
        a128::body(Qb + q0, (const unsigned char*)Kb + k0, (const unsigned char*)Vb + k0, Ob + q0, isl ? KVLEN : CL, (LAS char*)(shm + 1024));
    }
}

DEVI void ph_wo_probe(const P& p, int l) {
    g8::PlainOrder S{}; S.A = (const char*)WSP(bf16_t, WS_O); S.B = (const char*)(WSP(bf16_t, WS_WO) + (size_t)l * 1024 * 1024); S.ng = 1; S.nM = R / 256; S.nN = 4; S.K = 1024;
    g8::EpiF32 e{WSP(float, WS_QKV), 1024}; g8::gemm_phase(G8LDS, 1024, S, e); __syncthreads(); }
DEVI void ph_wo(const P& p, int l) {
    g8::PlainOrder S{}; S.A = (const char*)WSP(bf16_t, WS_O); S.B = (const char*)(WSP(bf16_t, WS_WO) + (size_t)l * 1024 * 1024); S.ng = 1; S.nM = (l == DEPTH - 1 ? RL : R) / 256; S.nN = 4; S.K = 1024;
    g8::EpiResid e{WSP(bf16_t, WS_X), WSP(float, WS_MODV) + (size_t)l * 9 * 6144 + 2 * 1024}; g8::gemm_phase(G8LDS, 1024, S, e); }

DEVI int block_excl_scan(int x, int& total, int* lds) {
    const int lane = TIDX & 63, wid = TIDX >> 6; int inc = x;
#pragma unroll
    for (int d = 1; d < 64; d <<= 1) { const int y = __shfl_up(inc, d); if (lane >= d) inc += y; }
    __syncthreads();
    if (lane == 63) lds[wid] = inc;
    __syncthreads();
    int base = 0, tot = 0;
#pragma unroll
    for (int w = 0; w < NWAVES; ++w) { const int v = lds[w]; if (w < wid) base += v; tot += v; }
    total = tot; return base + inc - x;
}
template <int VPT>
DEVI void select_topk(const P& p, int e, int n, int cap, int rowbase, int listbase, unsigned* lds) {
    const int tid = TIDX; const float* aff = WSP(float, WS_AFF);
    unsigned* hist = lds; unsigned* sel = lds + 256; int* scn = (int*)(lds + 272);
    unsigned v[VPT]; bool valid[VPT];
#pragma unroll
    for (int i = 0; i < VPT; ++i) { const int idx = tid * VPT + i; valid[i] = idx < n; v[i] = valid[i] ? __float_as_uint(aff[(size_t)(rowbase + idx) * 16 + e]) : 0u; }
    unsigned prefix = 0u, mask = 0u; int need = cap;
    for (int pass = 0; pass < 4; ++pass) {
        const int shift = 24 - 8 * pass;
        if (tid < 256) hist[tid] = 0u;
        __syncthreads();
#pragma unroll
        for (int i = 0; i < VPT; ++i) if (valid[i] && (v[i] & mask) == prefix) atomicAdd(&hist[(v[i] >> shift) & 255u], 1u);
        __syncthreads();
        {
          unsigned hv = 0u, sfx = 0u; const int ln = tid & 63, wv = tid >> 6;
          if (tid < 256) { hv = hist[tid]; sfx = hv;
#pragma unroll
              for (int dd = 1; dd < 64; dd <<= 1) { const unsigned y = __shfl_down(sfx, dd); if (ln + dd < 64) sfx += y; }
              if (ln == 0) sel[4 + wv] = sfx; }
          __syncthreads();
          if (tid < 256) { for (int w = wv + 1; w < 4; ++w) sfx += sel[4 + w]; const unsigned above = sfx - hv;
              if ((int)above < need && need <= (int)sfx) { sel[0] = (unsigned)tid; sel[1] = (unsigned)(need - (int)above); } } }
        __syncthreads();
        prefix |= sel[0] << shift; mask |= 255u << shift; need = (int)sel[1];
        __syncthreads();
    }
    int ceq = 0;
#pragma unroll
    for (int i = 0; i < VPT; ++i) ceq += (valid[i] && v[i] == prefix) ? 1 : 0;
    int tot; int eqr = block_excl_scan(ceq, tot, scn);
    bool take[VPT]; int ct = 0;
#pragma unroll
    for (int i = 0; i < VPT; ++i) { take[i] = valid[i] && (v[i] > prefix || (v[i] == prefix && eqr < need)); if (valid[i] && v[i] == prefix) ++eqr; ct += take[i] ? 1 : 0; }
    int pos = block_excl_scan(ct, tot, scn);
    int* IDX = WSP(int, WS_IDX); float* GATE = WSP(float, WS_GATE); int* SLOT = WSP(int, WS_SLOT);
#pragma unroll
    for (int i = 0; i < VPT; ++i) if (valid[i]) { const int row = rowbase + tid * VPT + i;
        if (take[i]) { IDX[e * EROWS + listbase + pos] = row; GATE[e * EROWS + listbase + pos] = __uint_as_float(v[i]); SLOT[(size_t)e * R + row] = listbase + pos; ++pos; }
        else SLOT[(size_t)e * R + row] = -1; }
    __syncthreads();
}
DEVI void ph_select(const P& p, int l, unsigned* lds) {
    const int nit = (l == DEPTH - 1) ? NB * NE : 2 * NB * NE;
    for (int item = BIDX; item < nit; item += gridDim.x) { const int q = item % (NB * NE), b = q / NE, e = q % NE;
        if (item < NB * NE) select_topk<8>(p, e, T, CAPL, b * T, b * CAPL, lds);
        else select_topk<1>(p, e, CL, CAPC, RL + b * CL, NB * CAPL + b * CAPC, lds); }
}
DEVI void ph_ffn1(const P& p, int l) {
    g8::ExpertOrder S{(const char*)WSP(bf16_t, WS_H), (const char*)WSP(bf16_t, WS_F1), WSP(int, WS_IDX), (size_t)4096 * 1024, l == DEPTH - 1 ? NB * CAPL / 256 : EROWS / 256, 16, 512, EROWS / 256};
    g8::EpiSwiGLU e{WSP(unsigned char, WS_HID)}; g8::gemm_phase<g8::EpiSwiGLU, g8::ExpertOrder, true, true>(G8LDS, 512, S, e, F1_SCALE); }
DEVI void ph_ffn2(const P& p, int l) {
    g8::ExpertOrder S{(const char*)WSP(bf16_t, WS_HID), (const char*)WSP(bf16_t, WS_F2), nullptr, (size_t)1024 * 2048, l == DEPTH - 1 ? NB * CAPL / 256 : EROWS / 256, 4, 1024, EROWS / 256};
    g8::EpiGate e{WSP(bf16_t, WS_YEXP), WSP(float, WS_GATE)}; g8::gemm_phase<g8::EpiGate, g8::ExpertOrder, false, true>(G8LDS, 1024, S, e, F2_SCALE); }

DEVI void ph_rwkv_mix(const P& p) {
    const int lane = TIDX & 63, gw = BIDX * NWAVES + (TIDX >> 6), nw = gridDim.x * NWAVES;
    const bf16_t* Hb = WSP(bf16_t, WS_H); bf16_t* xm = WSP(bf16_t, WS_U1);
    f32x4 mu[6][4];
#pragma unroll
    for (int j = 0; j < 6; ++j)
#pragma unroll
        for (int i = 0; i < 4; ++i) mu[j][i] = *(const f32x4*)(p.c_mu + j * 1024 + 4 * lane + 256 * i);
    for (int row = gw; row < R; row += nw) {
        int tt, len; if (row < RL) { tt = row & 4095; len = T; } else { tt = (row - RL) & 255; len = CL; }
        const size_t o0 = (size_t)row * D + 4 * lane; f32x4 h[4], hp[4], hn[4]; u32x2 hw[4], pw[4], nw2[4];
        const float mp = tt > 0 ? 1.f : 0.f, mn2 = tt < len - 1 ? 1.f : 0.f; const size_t op = tt > 0 ? o0 - D : o0, on2 = tt < len - 1 ? o0 + D : o0;
#pragma unroll
        for (int i = 0; i < 4; ++i) { hw[i] = *(const u32x2*)(Hb + o0 + 256 * i); pw[i] = *(const u32x2*)(Hb + op + 256 * i); nw2[i] = *(const u32x2*)(Hb + on2 + 256 * i); }
#pragma unroll
        for (int i = 0; i < 4; ++i) { h[i] = (f32x4){bflo(hw[i][0]), bfhi(hw[i][0]), bflo(hw[i][1]), bfhi(hw[i][1])}; hp[i] = (f32x4){bflo(pw[i][0]), bfhi(pw[i][0]), bflo(pw[i][1]), bfhi(pw[i][1])} * mp; hn[i] = (f32x4){bflo(nw2[i][0]), bfhi(nw2[i][0]), bflo(nw2[i][1]), bfhi(nw2[i][1])} * mn2; }
#pragma unroll
        for (int i = 0; i < 4; ++i) { const f32x4 xx = (hp[i] + hn[i]) * 0.5f - h[i];
#pragma unroll
            for (int j = 0; j < 6; ++j) { const f32x4 v = h[i] + xx * mu[j][i];
                const int slot = j == 0 ? 0 : (j == 1 ? 3 : (j == 2 ? 1 : (j == 3 ? 2 : j)));
                u32x2 w = {cvt_pk_bf16(v[0], v[1]), cvt_pk_bf16(v[2], v[3])}; *(u32x2*)(xm + (size_t)slot * R * D + o0 + 256 * i) = w; } }
    }
}
DEVI void ph_rwkv_gemm1(const P& p) {
    const size_t S = (size_t)R * D; bf16_t* l1 = WSP(bf16_t, WS_L1);
    g8::G1Order O{(const char*)WSP(bf16_t, WS_U1), (const char*)WSP(bf16_t, WS_WRKV), (const char*)WSP(bf16_t, WS_WL1), S * 2, R / 256};
    g8::EpiG1 e{WSP(bf16_t, WS_RKVB), S, l1, l1 + (size_t)R * 256}; g8::gemm_phase(G8LDS, 1024, O, e);
}
DEVI void ph_rwkv_gemm2(const P& p) {
    const size_t S = (size_t)R * D; const bf16_t* l1 = WSP(bf16_t, WS_L1); const bf16_t* wl2 = WSP(bf16_t, WS_WL2);
    { g8::PlainOrder O{}; O.A = (const char*)l1; O.B = (const char*)wl2; O.ng = 1; O.nM = R / 256; O.nN = 16; O.K = 256;
      g8::EpiWA e{WSP(bf16_t, WS_U1), S, (bf16_t*)(WSP(float, WS_U1) + 2 * S), p.c_w0, p.c_a0}; g8::gemm_phase(G8LDS, 256, O, e); }
    __syncthreads();
    { g8::PlainOrder O{}; O.A = (const char*)(l1 + (size_t)R * 256); O.B = (const char*)(wl2 + (size_t)4096 * 256); O.ng = 1; O.nM = R / 256; O.nN = 4; O.K = 128;
      g8::EpiBf16 e{WSP(bf16_t, WS_GB), 0, 1024}; g8::gemm_phase(G8LDS, 128, O, e); }
}
DEVI float dpp_sum16(float v) {
    v += __builtin_bit_cast(float, __builtin_amdgcn_update_dpp(0, __builtin_bit_cast(int, v), 0xB1, 0xF, 0xF, true));
    v += __builtin_bit_cast(float, __builtin_amdgcn_update_dpp(0, __builtin_bit_cast(int, v), 0x4E, 0xF, 0xF, true));
    v += __builtin_bit_cast(float, __builtin_amdgcn_update_dpp(0, __builtin_bit_cast(int, v), 0x141, 0xF, 0xF, true));
    v += __builtin_bit_cast(float, __builtin_amdgcn_update_dpp(0, __builtin_bit_cast(int, v), 0x140, 0xF, 0xF, true));
    return v;
}
DEVI void ph_rwkv_scan(const P& p, float* lds) {
    const int tid = TIDX, lane = tid & 63, wid = tid >> 6, jg = lane & 15, ip = wid * 4 + (lane >> 4);
    const size_t SZ = (size_t)R * D; const bf16_t* rkv = WSP(bf16_t, WS_RKVB); const float* wd = WSP(float, WS_U1); const float* ad = wd + 2 * SZ; float* ofb = WSP(float, WS_OFB);
    constexpr int NCH = (CL + T) / 32;
    float* obuf = lds + 2 * 32 * 384;
    for (int chain = BIDX; chain < 2 * NB * 16; chain += gridDim.x) {
        const int d = chain / (NB * 16), b = (chain / 16) % NB, h = chain % 16, col = h * 64 + lane;
        const float kk_c = p.c_k_k[col], ka_c = p.c_k_a[col];
        auto row_of = [&](int g) { return g < CL ? RL + b * CL + (d == 0 ? g : CL - 1 - g) : b * T + (d == 0 ? g - CL : T - 1 - (g - CL)); };
        bf16_t pr[4], pk[4], pv[4]; float pw[4], pa[4];
        auto issue = [&](int ci) {
#pragma unroll
            for (int q = 0; q < 4; ++q) { const size_t o = (size_t)row_of(ci * 32 + wid + 8 * q) * D + col; pr[q] = rkv[o]; pk[q] = rkv[SZ + o]; pv[q] = rkv[2 * SZ + o]; pw[q] = wd[d * SZ + o]; pa[q] = ad[d * SZ + o]; } };
        auto stage = [&](int buf) {
#pragma unroll
            for (int q = 0; q < 4; ++q) { const float r = bf2f(pr[q]), k = bf2f(pk[q]), v = bf2f(pv[q]), w = pw[q], a = pa[q];
                const float kkv = k * kk_c; const float ss = wave_sum(kkv * kkv); const float kkn = kkv * rsqrtf(fmaxf(ss, 1e-24f));
                float* vs = lds + buf * (32 * 384) + (wid + 8 * q) * 384; vs[lane] = r; vs[64 + lane] = w; vs[128 + lane] = k * (1.f + (a - 1.f) * ka_c); vs[192 + lane] = -kkn; vs[256 + lane] = kkn * a; vs[320 + lane] = v; } };
        f32x2 S00 = {0.f, 0.f}, S01 = {0.f, 0.f}, S10 = {0.f, 0.f}, S11 = {0.f, 0.f};
        __syncthreads();
        issue(0); stage(0);
        __syncthreads();
        for (int ci = 0; ci < NCH; ++ci) {
            if (ci + 1 < NCH) issue(ci + 1);
            const float* vb = lds + (ci & 1) * (32 * 384) + 4 * jg; const float* vv = lds + (ci & 1) * (32 * 384) + 320 + 2 * ip;
            f32x4 r4 = *(const f32x4*)vb, w4 = *(const f32x4*)(vb + 64), k4 = *(const f32x4*)(vb + 128), a4 = *(const f32x4*)(vb + 192), b4 = *(const f32x4*)(vb + 256); f32x2 v2 = *(const f32x2*)vv;
#pragma unroll 4
            for (int s = 0; s < 32; ++s) {
                const int sn = s < 31 ? s + 1 : 31;
                const f32x4 r4n = *(const f32x4*)(vb + sn * 384), w4n = *(const f32x4*)(vb + sn * 384 + 64), k4n = *(const f32x4*)(vb + sn * 384 + 128), a4n = *(const f32x4*)(vb + sn * 384 + 192), b4n = *(const f32x4*)(vb + sn * 384 + 256);
                const f32x2 v2n = *(const f32x2*)(vv + sn * 384);
                const f32x2 a01 = {a4[0], a4[1]}, a23 = {a4[2], a4[3]}, w01 = {w4[0], w4[1]}, w23 = {w4[2], w4[3]}, b01 = {b4[0], b4[1]}, b23 = {b4[2], b4[3]}, k01 = {k4[0], k4[1]}, k23 = {k4[2], k4[3]}, r01 = {r4[0], r4[1]}, r23 = {r4[2], r4[3]};
                f32x2 t0 = S00 * a01 + S01 * a23, t1 = S10 * a01 + S11 * a23;
                const float sa0 = dpp_sum16(t0[0] + t0[1]), sa1 = dpp_sum16(t1[0] + t1[1]);
                const f32x2 sa0v = {sa0, sa0}, sa1v = {sa1, sa1}, v0v = {v2[0], v2[0]}, v1v = {v2[1], v2[1]};
                S00 = S00 * w01 + sa0v * b01 + v0v * k01; S01 = S01 * w23 + sa0v * b23 + v0v * k23;
                S10 = S10 * w01 + sa1v * b01 + v1v * k01; S11 = S11 * w23 + sa1v * b23 + v1v * k23;
                t0 = S00 * r01 + S01 * r23; t1 = S10 * r01 + S11 * r23;
                const float o0 = dpp_sum16(t0[0] + t0[1]), o1 = dpp_sum16(t1[0] + t1[1]);
                if (jg == 0) *(f32x2*)(obuf + s * 64 + 2 * ip) = (f32x2){o0, o1};
                r4 = r4n; w4 = w4n; k4 = k4n; a4 = a4n; b4 = b4n; v2 = v2n;
            }
            __syncthreads();
            { const int s = tid >> 4, i4 = (tid & 15) * 4; *(f32x4*)(ofb + d * SZ + (size_t)row_of(ci * 32 + s) * D + h * 64 + i4) = *(const f32x4*)(obuf + s * 64 + i4); }
            if (ci + 1 < NCH) stage((ci + 1) & 1);
            __syncthreads();
        }
    }
}
namespace sc2 {
constexpr int SLOT = 11520;
DEVI int perm16(int t) { return 8 * ((t >> 2) & 1) + 4 * ((t >> 3) & 1) + (t & 3); }
DEVI float hsel(float x, int hi) { auto rr = __builtin_amdgcn_permlane32_swap(__float_as_uint(x), __float_as_uint(x), false, false); return __uint_as_float(hi ? rr[1] : rr[0]); }
DEVI void st16(LAS char* p, float v) { *(LAS unsigned short*)p = f2bf(v); }
template <int S> DEVI float bcast(float x) { return __builtin_bit_cast(float, __builtin_amdgcn_update_dpp(0, __builtin_bit_cast(int, x), 0x150 + S, 0xF, 0xF, true)); }
struct Raw { bf16_t ra[16], ka[16], va[16], sa[16], wa[16]; };
template <class RowOf>
DEVI void load_raw(const P& p, int d, int h, int c, Raw& w, RowOf row_of) {
    const int lane = TIDX & 63, col = h * 64 + lane; const size_t SZ = (size_t)R * D;
    const bf16_t* rkv = WSP(bf16_t, WS_RKVB); const bf16_t* wd = WSP(bf16_t, WS_U1) + (size_t)d * SZ; const bf16_t* ad = (const bf16_t*)(WSP(float, WS_U1) + 2 * SZ) + (size_t)d * SZ;
    bf16_t (&ra)[16] = w.ra, (&ka)[16] = w.ka, (&va)[16] = w.va, (&sa)[16] = w.sa, (&wa)[16] = w.wa;
    const int row0 = row_of(16 * c), rstep = row_of(16 * c + 1) - row0;
#pragma unroll
    for (int t = 0; t < 16; ++t) { const size_t ro = (size_t)__builtin_amdgcn_readfirstlane(row0 + rstep * t) * D;
        const bf16_t* r0 = rkv + ro; const bf16_t* r1 = rkv + SZ + ro; const bf16_t* r2 = rkv + 2 * SZ + ro; const bf16_t* r3 = wd + ro; const bf16_t* r4 = ad + ro;
        ra[t] = r0[col]; ka[t] = r1[col]; va[t] = r2[col]; wa[t] = r3[col]; sa[t] = r4[col]; }
}
DEVI void produce(const Raw& w, float kk_c, float ka_c, LAS char* slot) {
    const int lane = TIDX & 63;
    float ra[16], ka[16], va[16], sa[16], wa[16];
#pragma unroll
    for (int t = 0; t < 16; ++t) { ra[t] = bf2f(w.ra[t]); ka[t] = bf2f(w.ka[t]); va[t] = bf2f(w.va[t]); sa[t] = bf2f(w.sa[t]); wa[t] = __builtin_amdgcn_exp2f(-bf2f(w.wa[t])); }
    float at[16], rt[16], bt[16], kt[16]; float g = 1.f;
#pragma unroll
    for (int t = 0; t < 16; ++t) { const float kkv = ka[t] * kk_c; const float ss = wave_sum_dpp(kkv * kkv); const float kkn = kkv * rsqrtf(fmaxf(ss, 1e-24f));
        const float kd = ka[t] * (1.f + (sa[t] - 1.f) * ka_c), bv = kkn * sa[t];
        at[t] = -kkn * g; g *= wa[t]; rt[t] = ra[t] * g; const float ig = __builtin_amdgcn_rcpf(g); bt[t] = bv * ig; kt[t] = kd * ig; }
    { const int cb = (lane >> 3), wb = (lane & 7) * 2;
#pragma unroll
      for (int t = 0; t < 16; ++t) { const int o0 = t * 128 + ((cb ^ (t & 7)) << 4) + wb, o1 = (16 + t) * 128 + ((cb ^ (t & 7)) << 4) + wb;
          st16(slot + o0, at[t]); st16(slot + o1, rt[t]); st16(slot + 4096 + o0, bt[t]); st16(slot + 4096 + o1, kt[t]); } }
    asm volatile("s_waitcnt lgkmcnt(0)" ::: "memory");
    f32x16 dm = {};
    { const int m = lane & 31, hi = lane >> 5;
#pragma unroll
      for (int q = 0; q < 4; ++q) { const int o = m * 128 + (((2 * q + hi) ^ (m & 7)) << 4); const bf16x8 A = *(const LAS bf16x8*)(slot + o), B = *(const LAS bf16x8*)(slot + 4096 + o);
          dm = __builtin_amdgcn_mfma_f32_32x32x16_bf16(A, B, dm, 0, 0, 0); } }
    { float bp[16], kp[16];
#pragma unroll
      for (int t = 0; t < 16; ++t) { bp[8 * ((t >> 2) & 1) + 4 * ((t >> 3) & 1) + (t & 3)] = bt[t] * g; kp[t] = kt[t] * g; }
      u32x4 w0 = {cvt_pk_bf16(bp[0], bp[1]), cvt_pk_bf16(bp[2], bp[3]), cvt_pk_bf16(bp[4], bp[5]), cvt_pk_bf16(bp[6], bp[7])}, w1 = {cvt_pk_bf16(bp[8], bp[9]), cvt_pk_bf16(bp[10], bp[11]), cvt_pk_bf16(bp[12], bp[13]), cvt_pk_bf16(bp[14], bp[15])};
      *(LAS u32x4*)(slot + 4096 + lane * 32) = w0; *(LAS u32x4*)(slot + 4096 + lane * 32 + 16) = w1;
      u32x4 k0 = {cvt_pk_bf16(kp[0], kp[1]), cvt_pk_bf16(kp[2], kp[3]), cvt_pk_bf16(kp[4], kp[5]), cvt_pk_bf16(kp[6], kp[7])}, k1 = {cvt_pk_bf16(kp[8], kp[9]), cvt_pk_bf16(kp[10], kp[11]), cvt_pk_bf16(kp[12], kp[13]), cvt_pk_bf16(kp[14], kp[15])};
      *(LAS u32x4*)(slot + 6144 + lane * 32) = k0; *(LAS u32x4*)(slot + 6144 + lane * 32 + 16) = k1;
      u32x4 v0 = {cvt_pk_bf16(va[0], va[1]), cvt_pk_bf16(va[2], va[3]), cvt_pk_bf16(va[4], va[5]), cvt_pk_bf16(va[6], va[7])}, v1 = {cvt_pk_bf16(va[8], va[9]), cvt_pk_bf16(va[10], va[11]), cvt_pk_bf16(va[12], va[13]), cvt_pk_bf16(va[14], va[15])};
      *(LAS u32x4*)(slot + 9216 + lane * 32) = v0; *(LAS u32x4*)(slot + 9216 + lane * 32 + 16) = v1;
      *(LAS float*)(slot + 11264 + lane * 4) = g; }
    __builtin_amdgcn_sched_barrier(0);
#define ROWS(m, x0, x1) do { const float _h = hsel(dm[((m) & 3) + 4 * ((m) >> 3)], ((m) >> 2) & 1); auto _rr = __builtin_amdgcn_permlane16_swap(__float_as_uint(_h), __float_as_uint(_h), false, false); x0 = __uint_as_float(_rr[0]); x1 = __uint_as_float(_rr[1]); } while (0)
    const int l16 = lane & 15;
#define SUB1(S) if (S < t) { const float nv = bcast<S>(nabt); acc = acc + (f32x2){nv, nv} * ap[S]; }
#define SUB2(S) if (S <= t) { const float mv = bcast<S>(mbrt); acc = acc + (f32x2){mv, mv} * ap[S]; }
#define ALL16(M) M(0) M(1) M(2) M(3) M(4) M(5) M(6) M(7) M(8) M(9) M(10) M(11) M(12) M(13) M(14) M(15)
    f32x2 ap[16], qg[16];
#pragma unroll
    for (int t = 0; t < 16; ++t) { float nabt, nakt; ROWS(t, nabt, nakt); f32x2 acc = {at[t], (l16 < t) ? nakt : 0.f}; ALL16(SUB1) ap[t] = acc; __builtin_amdgcn_sched_barrier(0); }
#pragma unroll
    for (int t = 0; t < 16; ++t) { float mbrt, mkrt; ROWS(16 + t, mbrt, mkrt); f32x2 acc = {rt[t], (l16 <= t) ? mkrt : 0.f}; ALL16(SUB2) qg[t] = acc; __builtin_amdgcn_sched_barrier(0); }
#undef SUB1
#undef SUB2
#undef ALL16
#undef ROWS
    { const int pj = (lane & ~12) | ((lane & 4) << 1) | ((lane & 8) >> 1), cb = pj >> 3, wb = (pj & 7) * 2;
#pragma unroll
      for (int t = 0; t < 16; ++t) { st16(slot + t * 128 + ((cb ^ (t & 7)) << 4) + wb, ap[t][0]); st16(slot + (16 + t) * 128 + ((cb ^ (t & 7)) << 4) + wb, qg[t][0]); } }
    if (lane < 16) {
#pragma unroll
        for (int t = 0; t < 16; ++t) { st16(slot + 8192 + t * 32 + l16 * 2, ap[t][1]); st16(slot + 8192 + (16 + t) * 32 + l16 * 2, qg[t][1]); } }
}
template <class RowOf>
DEVI void consume(f32x16& ST0, f32x16& ST1, const LAS char* slot, int it, int c, bf16_t* out  , RowOf row_of) {
    const int lane = TIDX & 63, n = lane & 31, hi = lane >> 5;
    f32x16 x = {};
#pragma unroll
    for (int q = 0; q < 4; ++q) { const f32x16& S = (q >> 1) ? ST1 : ST0; const int r0 = 8 * (q & 1);
        const u32x4 w = {cvt_pk_bf16(S[r0], S[r0 + 1]), cvt_pk_bf16(S[r0 + 2], S[r0 + 3]), cvt_pk_bf16(S[r0 + 4], S[r0 + 5]), cvt_pk_bf16(S[r0 + 6], S[r0 + 7])};
        const bf16x8 A = *(const LAS bf16x8*)(slot + n * 128 + (((2 * q + hi) ^ (n & 7)) << 4));
        x = __builtin_amdgcn_mfma_f32_32x32x16_bf16(A, __builtin_bit_cast(bf16x8, w), x, 0, 0, 0); }
    const bf16x8 vf = *(const LAS bf16x8*)(slot + 9216 + (32 * it + n) * 32 + hi * 16);
    { const bf16x8 A5 = *(const LAS bf16x8*)(slot + 8192 + n * 32 + hi * 16); x = __builtin_amdgcn_mfma_f32_32x32x16_bf16(A5, vf, x, 0, 0, 0); }
    const u32x4 uw = {cvt_pk_bf16(x[0], x[1]), cvt_pk_bf16(x[2], x[3]), cvt_pk_bf16(x[4], x[5]), cvt_pk_bf16(x[6], x[7])}; const bf16x8 ub = __builtin_bit_cast(bf16x8, uw);
#pragma unroll
    for (int r = 8; r < 16; ++r) { const int t = (r & 3) + 8 * ((r >> 2) - 2) + 4 * hi; out[(size_t)row_of(16 * c + t) * D + n] = f2bf(x[r]); }
#pragma unroll
    for (int jt = 0; jt < 2; ++jt) { f32x16& S = jt ? ST1 : ST0; f32x16 C;
#pragma unroll
        for (int gq = 0; gq < 4; ++gq) { const f32x4 gv = *(const LAS f32x4*)(slot + 11264 + (32 * jt + 8 * gq + 4 * hi) * 4);
#pragma unroll
            for (int e = 0; e < 4; ++e) C[4 * gq + e] = S[4 * gq + e] * gv[e]; }
        const bf16x8 Ab = *(const LAS bf16x8*)(slot + 4096 + (32 * jt + n) * 32 + hi * 16), Ak = *(const LAS bf16x8*)(slot + 6144 + (32 * jt + n) * 32 + hi * 16);
        C = __builtin_amdgcn_mfma_f32_32x32x16_bf16(Ab, ub, C, 0, 0, 0); C = __builtin_amdgcn_mfma_f32_32x32x16_bf16(Ak, vf, C, 0, 0, 0); S = C; }
}
}
DEVI void ph_rwkv_scan2(const P& p) {
    const int wid = __builtin_amdgcn_readfirstlane(TIDX >> 6), lane = TIDX & 63; const size_t SZ = (size_t)R * D;
    LAS char* slots = (LAS char*)(shm + 1024);
    for (int chain = BIDX; chain < 2 * NB * 16; chain += gridDim.x) {
        const int d = chain / (NB * 16), b = (chain / 16) % NB, h = chain % 16;
        const float kk_c = p.c_k_k[h * 64 + lane], ka_c = p.c_k_a[h * 64 + lane];
        auto row_of = [&](int g) { return g < CL ? RL + b * CL + (d == 0 ? g : CL - 1 - g) : b * T + (d == 0 ? g - CL : T - 1 - (g - CL)); };
        f32x16 ST0 = {}, ST1 = {};
        bf16_t* out = WSP(bf16_t, WS_OFB) + (size_t)d * SZ + h * 64 + 32 * (wid & 1);
        constexpr int NCHUNK = (CL + T) / 16, PB = 6, NBATCH = (NCHUNK + PB - 1) / PB;
        const int pw = wid - 2;
        sc2::Raw raw;
        if (wid >= 2) { sc2::load_raw(p, d, h, pw, raw, row_of); sc2::produce(raw, kk_c, ka_c, slots + pw * sc2::SLOT); sc2::load_raw(p, d, h, PB + pw, raw, row_of); }
        __syncthreads();
#pragma unroll 1
        for (int bi = 0; bi < NBATCH; ++bi) {
            if (wid >= 2) { const int c = PB * (bi + 1) + pw;
                if (c < NCHUNK) { sc2::produce(raw, kk_c, ka_c, slots + (((bi + 1) & 1) * PB + pw) * sc2::SLOT);
                    if (c + PB < NCHUNK) sc2::load_raw(p, d, h, c + PB, raw, row_of); } }
            else { const int n = NCHUNK - PB * bi < PB ? NCHUNK - PB * bi : PB;
#pragma unroll 1
                for (int s2 = 0; s2 < n; ++s2) sc2::consume(ST0, ST1, slots + ((bi & 1) * PB + s2) * sc2::SLOT, wid, PB * bi + s2, out, row_of); }
            __syncthreads();
        }
    }
}
DEVI void ph_rwkv_readout(const P& p) {
    const int lane = TIDX & 63, gw = BIDX * NWAVES + (TIDX >> 6), nw = gridDim.x * NWAVES;
    const size_t SZ = (size_t)R * D; const bf16_t* rkv = WSP(bf16_t, WS_RKVB); const bf16_t* ad = (const bf16_t*)(WSP(float, WS_U1) + 2 * SZ); const bf16_t* ofb = WSP(bf16_t, WS_OFB);
    const bf16_t* gb = WSP(bf16_t, WS_GB); bf16_t* O = WSP(bf16_t, WS_O);
    f32x4 ka[4], rk0[4], rk1[4], lw[4], lb[4];
#pragma unroll
    for (int i = 0; i < 4; ++i) { const int c0 = 4 * lane + 256 * i; ka[i] = *(const f32x4*)(p.c_k_a + c0); rk0[i] = *(const f32x4*)(p.c_r_k + c0); rk1[i] = *(const f32x4*)(p.c_r_k + 1024 + c0);
        lw[i] = *(const f32x4*)(p.c_ln_w + c0); lb[i] = *(const f32x4*)(p.c_ln_b + c0); }
    for (int row = gw; row < R; row += nw) {
        const size_t o0 = (size_t)row * D + 4 * lane;
        u32x2 ofw[4], obw[4], a0w[4], a1w[4], rw[4], kw[4], vw[4], gw2[4];
#pragma unroll
        for (int i = 0; i < 4; ++i) { const size_t o = o0 + 256 * i; ofw[i] = *(const u32x2*)(ofb + o); obw[i] = *(const u32x2*)(ofb + SZ + o); a0w[i] = *(const u32x2*)(ad + o); a1w[i] = *(const u32x2*)(ad + SZ + o);
            rw[i] = *(const u32x2*)(rkv + o); kw[i] = *(const u32x2*)(rkv + SZ + o); vw[i] = *(const u32x2*)(rkv + 2 * SZ + o); gw2[i] = *(const u32x2*)(gb + o); }
#pragma unroll
        for (int i = 0; i < 4; ++i) {
            const f32x4 a0i = {bflo(a0w[i][0]), bfhi(a0w[i][0]), bflo(a0w[i][1]), bfhi(a0w[i][1])}, a1i = {bflo(a1w[i][0]), bfhi(a1w[i][0]), bflo(a1w[i][1]), bfhi(a1w[i][1])};
            f32x4 ov = (f32x4){bflo(ofw[i][0]) + bflo(obw[i][0]), bfhi(ofw[i][0]) + bfhi(obw[i][0]), bflo(ofw[i][1]) + bflo(obw[i][1]), bfhi(ofw[i][1]) + bfhi(obw[i][1])};
            const float mean = dpp_sum16(ov[0] + ov[1] + ov[2] + ov[3]) * (1.f / 64.f); ov = ov - mean;
            const float var = dpp_sum16(ov[0] * ov[0] + ov[1] * ov[1] + ov[2] * ov[2] + ov[3] * ov[3]) * (1.f / 64.f); ov = ov * rsqrtf(var + 64e-5f);
            const f32x4 r = {bflo(rw[i][0]), bfhi(rw[i][0]), bflo(rw[i][1]), bfhi(rw[i][1])}, k = {bflo(kw[i][0]), bfhi(kw[i][0]), bflo(kw[i][1]), bfhi(kw[i][1])};
            const f32x4 v = {bflo(vw[i][0]), bfhi(vw[i][0]), bflo(vw[i][1]), bfhi(vw[i][1])}, g = {bflo(gw2[i][0]), bfhi(gw2[i][0]), bflo(gw2[i][1]), bfhi(gw2[i][1])};
            const f32x4 t0 = r * (k * ((a0i - 1.f) * ka[i] + 1.f)) * rk0[i], t1 = r * (k * ((a1i - 1.f) * ka[i] + 1.f)) * rk1[i];
            const float bs = dpp_sum16(t0[0] + t0[1] + t0[2] + t0[3] + t1[0] + t1[1] + t1[2] + t1[3]);
            const f32x4 res = (ov * lw[i] + lb[i] + v * bs) * g;
            u32x2 w = {cvt_pk_bf16(res[0], res[1]), cvt_pk_bf16(res[2], res[3])}; *(u32x2*)(O + o0 + 256 * i) = w; }
    }
}

typedef const P __attribute__((address_space(4)))* KP;
#define LDSF ((float*)(shm + 64))
DEVI P load_params(KP kp) { P p; __builtin_memcpy(&p, kp, sizeof(P)); return p; }
#ifndef PROBE_DUP
#define PROBE_DUP 0
#endif
#define PHASE_FN(name, call) DEVI void name(KP kp0, int l) { KP kp = kp0; asm volatile("" : "+s"(kp)); const P p = load_params(kp); (void)l; call; }
#define PHASE_FN_D(id, name, call) DEVI void name(KP kp0, int l) { KP kp = kp0; asm volatile("" : "+s"(kp)); const P p = load_params(kp); (void)l; call; if ((PROBE_DUP >> id) & 1) { __syncthreads(); call; } }
PHASE_FN(f_prologue, { ph_prologue(p, LDSF); if ((PROBE_DUP >> 17) & 1) { __syncthreads(); ph_prologue(p, LDSF); } })
PHASE_FN(f_norm1, { if ((PROBE_DUP >> 14) & 1) ph_norm1<false>(p, l); ph_norm1(p, l); cvt_ffn_norm1(p, l, LDSF); })
PHASE_FN(f_qkv_gemm, { ph_qkv_gemm(p, l); cvt_ffn_tail(p, l, LDSF, 1, (R / 256) * 6); })
PHASE_FN_D(2, f_qkv_post, ph_qkv_post(p, l))
PHASE_FN_D(3, f_attn_a, ph_attn_a(p, l))
PHASE_FN_D(4, f_attn_b, ph_attn_b(p, l))
PHASE_FN(f_wo, { if ((PROBE_DUP >> 15) & 1) ph_wo_probe(p, l); ph_wo(p, l); cvt_ffn_tail(p, l, LDSF, 2, (R / 256) * 4); })
PHASE_FN_D(5, f_mix, ph_rwkv_mix(p))
PHASE_FN_D(6, f_g1, ph_rwkv_gemm1(p))
PHASE_FN_D(7, f_g2, ph_rwkv_gemm2(p))
PHASE_FN_D(8, f_scan, ph_rwkv_scan2(p))
PHASE_FN_D(9, f_readout, ph_rwkv_readout(p))
PHASE_FN_D(10, f_norm2, ph_norm2(p, l, LDSF))
PHASE_FN_D(11, f_select, ph_select(p, l, (unsigned*)LDSF))
PHASE_FN(f_ffn1, { ph_ffn1(p, l); if ((PROBE_DUP >> 12) & 1) { __syncthreads(); ph_ffn1(p, l); } })
PHASE_FN(f_ffn2, { ph_ffn2(p, l); if (l + 1 < DEPTH) cvt_ffn_tail(p, l + 1, LDSF, 0, NE * (EROWS / 256) * 4); })
PHASE_FN(f_final, ph_final(p))

__global__ void __launch_bounds__(NTHREADS, 2) mega(P parg) {
    KP kp = (KP)__builtin_amdgcn_kernarg_segment_ptr();
    volatile LAS unsigned* xbw = (volatile LAS unsigned*)shm;
    if (threadIdx.x == 0) { xbw[0] = 0u; xbw[1] = 0u; xbw[2] = 0u; xbw[3] = 0u; }
    __syncthreads();
    XcdBarrier bar = xcd_barrier_post((unsigned*)(parg.ws + WS_BAR), xbw);
    int ph = 0; const int lo = parg.ph_lo, hi = parg.ph_hi;
#ifndef PROBE_XBAR
#define PROBE_XBAR 0
#endif
#define PH(fn, l) do { if (ph >= lo && ph < hi) { if (ph > lo) { xcd_barrier(bar); if (PROBE_XBAR) xcd_barrier(bar); } fn(kp, l); } ++ph; } while (0)
    PH(f_prologue, 0);
#pragma unroll 1
    for (int l = 0; l < DEPTH; ++l) {
        const int kind = l % 3;
        PH(f_norm1, l);
        if (kind == 0) { PH(f_qkv_gemm, l); PH(f_attn_a, l); PH(f_wo, l); }
        else if (kind == 1) { PH(f_qkv_gemm, l); PH(f_attn_b, l); PH(f_wo, l); }
        else { PH(f_mix, l); PH(f_g1, l); PH(f_g2, l); PH(f_scan, l); PH(f_readout, l); PH(f_wo, l); }
        PH(f_norm2, l); PH(f_select, l); PH(f_ffn1, l); PH(f_ffn2, l);
    }
    PH(f_final, DEPTH);
#undef PH
}

#ifndef MK_DEBUG
#define MK_DEBUG 0
#endif
constexpr size_t WS_DBG = 32768;
__global__ void dbg_chk(const void* ptr, size_t n, int type, unsigned* dbg, unsigned code) {
    unsigned bad = 0;
    for (size_t i = (size_t)blockIdx.x * blockDim.x + threadIdx.x; i < n; i += (size_t)gridDim.x * blockDim.x) {
        if (type == 0) { const float v = ((const float*)ptr)[i]; if (!(fabsf(v) < 1e6f)) bad = 1; }
        else if (type == 1) { const float v = bf2f(((const bf16_t*)ptr)[i]); if (!(fabsf(v) < 1e6f)) bad = 1; }
        else { const int v = ((const int*)ptr)[i]; if (v < 0 || v >= R) bad = 1; }
    }
    if (bad) atomicMax(dbg, 1000u - code);
}
__global__ void dbg_final(float* out, size_t n, unsigned* dbg) {
    __shared__ unsigned anybad;
    if (threadIdx.x == 0) anybad = 0; __syncthreads();
    unsigned bad = 0;
    for (size_t i = (size_t)blockIdx.x * blockDim.x + threadIdx.x; i < n; i += (size_t)gridDim.x * blockDim.x) { const float v = out[i]; if (!(fabsf(v) < 1e6f)) bad = 1; }
    if (bad) atomicMax(dbg + 64, 1u);
}
__global__ void dbg_write(float* out, size_t n, const unsigned* dbg) {
    const unsigned d = dbg[0], f = dbg[64]; if (d == 0 && f == 0) return;
    const float code = d ? (float)(1000u - d) * 100.f : 9900.f;
    for (size_t i = (size_t)blockIdx.x * blockDim.x + threadIdx.x; i < n; i += (size_t)gridDim.x * blockDim.x) out[i] = code;
}

constexpr int N_PHASES = 1 + 3 * 8 + 11 + 1;

extern "C" void kernel_launch(void* const* d_in, const int* in_sizes, int n_in, void* d_out, int out_size, void* d_ws, size_t ws_size, hipStream_t stream) {
    static int grid = 0;
    if (grid == 0) {
        if (n_in != 34 || in_sizes[0] != RL * D || out_size != RL * D || ws_size < WS_END) { fprintf(stderr, "kernel_launch: unexpected shapes: n_in %d in0 %d out %d ws %zu (need %zu)\n", n_in, n_in > 0 ? in_sizes[0] : -1, out_size, ws_size, (size_t)WS_END); grid = -1; return; }
        int dev = 0, cus = 0, per_cu = 0;
        if (hipGetDevice(&dev) != hipSuccess || hipDeviceGetAttribute(&cus, hipDeviceAttributeMultiprocessorCount, dev) != hipSuccess) { grid = -1; return; }
        if (hipFuncSetAttribute((const void*)mega, hipFuncAttributeMaxDynamicSharedMemorySize, LDS_BYTES) != hipSuccess) { fprintf(stderr, "kernel_launch: hipFuncSetAttribute failed\n"); grid = -1; return; }
        if (hipOccupancyMaxActiveBlocksPerMultiprocessor(&per_cu, (const void*)mega, NTHREADS, LDS_BYTES) != hipSuccess || per_cu < 1) fprintf(stderr, "kernel_launch: occupancy query says %d\n", per_cu);
        (void)hipGetLastError();
        grid = cus;
    }
    if (grid < 0) return;
    (void)hipMemsetAsync((char*)d_ws + WS_BAR, 0, 65536, stream);
    P p{};
    const float** pf = (const float**)&p;
    for (int i = 0; i < 34; ++i) pf[i] = (const float*)d_in[i];
    p.out = (float*)d_out; p.ws = (unsigned char*)d_ws;
#if MK_PER_PHASE
    for (int ph = 0; ph < N_PHASES; ++ph) { p.ph_lo = ph; p.ph_hi = ph + 1; hipLaunchKernelGGL(mega, dim3(grid), dim3(NTHREADS), LDS_BYTES, stream, p);
#if MK_DEBUG
        unsigned char* w = (unsigned char*)d_ws; unsigned* dbg = (unsigned*)(w + WS_DBG); const size_t RD = (size_t)R * D;
        auto CH = [&](size_t off, size_t n, int type) { hipLaunchKernelGGL(dbg_chk, dim3(1024), dim3(256), 0, stream, (const void*)(w + off), n, type, dbg, (unsigned)(ph + 1)); };
        int l = -1, loc = -1, kind = -1; { int q = ph - 1; if (ph == 0) loc = -1; else if (ph == N_PHASES - 1) loc = -2; else { for (l = 0; l < DEPTH; ++l) { const int np = (l % 3 == 2) ? 11 : 9; if (q < np) { loc = q; break; } q -= np; } kind = l % 3; } }
        if (ph == 0) { CH(WS_MODV, (size_t)DEPTH * 9 * 6144, 0); CH(WS_ROPE, 6144, 0); CH(WS_WQKV, (size_t)3 * 1536 * 1024, 1); CH(WS_WO, (size_t)4 * 1024 * 1024, 1); CH(WS_WRKV, (size_t)3 * 1024 * 1024, 1); CH(WS_WL1, (size_t)3 * 128 * 1024, 1); CH(WS_WL2, (size_t)(4 * 1024 * 64 + 1024 * 128), 1); }
        else if (loc >= 0) {
            const int nm = kind == 2 ? 6 : 4;
            if (loc == 0) { CH(WS_X, RD, 1); if (kind == 2) CH(WS_OFB, RD, 0); else CH(WS_H, RD, 1); CH(WS_F1, (size_t)NE * 4096 * 1024, 1); CH(WS_F2, (size_t)NE * 1024 * 2048, 1); }
            else if (loc <= nm) {
                if (kind != 2) { if (loc == 1) CH(WS_QKV, (size_t)R * 1536, 0); if (loc == 2) { CH(WS_QB, RD, 1); CH(WS_KB, (size_t)NB * KVLEN * 256, 1); CH(WS_VT, (size_t)NB * KVLEN * 256, 1); } if (loc == 3) CH(WS_O, RD, 1); if (loc == 4) CH(WS_X, RD, 1); }
                else { if (loc == 1) CH(WS_U1, 6 * RD, 1); if (loc == 2) { CH(WS_RKVB, 3 * RD, 1); CH(WS_L1, (size_t)3 * R * 128, 1); } if (loc == 3) { CH(WS_U1, 4 * RD, 0); CH(WS_GB, RD, 1); } if (loc == 4) CH(WS_OFB, 2 * RD, 0); if (loc == 5) CH(WS_O, RD, 1); if (loc == 6) CH(WS_X, RD, 1); }
            } else { const int m = loc - nm;
                if (m == 1) { CH(WS_H, RD, 1); CH(WS_AFF, (size_t)R * 16, 0); } if (m == 2) { CH(WS_GATE, PAIRS, 0); CH(WS_IDX, PAIRS, 2); } if (m == 3) CH(WS_HID, (size_t)PAIRS * FF, 1); if (m == 4) CH(WS_YEXP, (size_t)PAIRS * D, 1); }
        }
        if (ph == N_PHASES - 1) { hipLaunchKernelGGL(dbg_final, dim3(1024), dim3(256), 0, stream, (float*)d_out, (size_t)RL * D, dbg); hipLaunchKernelGGL(dbg_write, dim3(1024), dim3(256), 0, stream, (float*)d_out, (size_t)RL * D, (const unsigned*)dbg); }
#endif
    }
#else
    p.ph_lo = 0; p.ph_hi = N_PHASES; hipLaunchKernelGGL(mega, dim3(grid), dim3(NTHREADS), LDS_BYTES, stream, p);
#endif
    const hipError_t le = hipPeekAtLastError();
    if (le != hipSuccess) fprintf(stderr, "kernel_launch: launch failed: %s\n", hipGetErrorName(le));
}
```

```cpp
#include <hip/hip_runtime.h>
#include <stdint.h>
#include <stdio.h>

#ifndef MK_PER_PHASE
#define MK_PER_PHASE 0
#endif

#define DEVI __device__ __forceinline__
typedef unsigned short bf16_t;
typedef short bf16x8 __attribute__((ext_vector_type(8)));
typedef short s16x4 __attribute__((ext_vector_type(4)));
typedef float f32x4 __attribute__((ext_vector_type(4)));
typedef float f32x16 __attribute__((ext_vector_type(16)));
typedef unsigned u32x4 __attribute__((ext_vector_type(4)));
typedef unsigned u32x2 __attribute__((ext_vector_type(2)));
typedef int i32x4 __attribute__((ext_vector_type(4)));
typedef int i32x8 __attribute__((ext_vector_type(8)));

extern __shared__ __attribute__((aligned(16))) unsigned char shm[];
constexpr int D = 1024, NB = 8, T = 4096, CL = 256, DEPTH = 4;
constexpr int RL = NB * T, RC = NB * CL, R = RL + RC;
constexpr int KVLEN = T + CL;
constexpr int NE = 16, FF = 2048, CAPL = 512, CAPC = 32, EROWS = NB * (CAPL + CAPC), PAIRS = NE * EROWS;
constexpr int NTHREADS = 512, NWAVES = 8;
constexpr int LDS_BYTES = 144 * 1024;

constexpr size_t al256(size_t x) { return (x + 255) / 256 * 256; }
constexpr size_t WS_BAR = 0;
constexpr size_t WS_MODV = 65536;
constexpr size_t WS_ROPE = WS_MODV + al256((size_t)DEPTH * 9 * 6 * D * 4);
constexpr size_t WS_WQKV = WS_ROPE + 32768;
constexpr size_t WS_WO = WS_WQKV + (size_t)3 * 1536 * 1024 * 2;
constexpr size_t WS_WRKV = WS_WO + (size_t)4 * 1024 * 1024 * 2;
constexpr size_t WS_WL1 = WS_WRKV + (size_t)3 * 1024 * 1024 * 2;
constexpr size_t WS_WL2 = WS_WL1 + (size_t)3 * 256 * 1024 * 2;
constexpr size_t WS_F1 = WS_WL2 + (size_t)(4096 * 256 + 1024 * 128) * 2;
constexpr size_t WS_F2 = WS_F1 + (size_t)NE * 4096 * 1024 * 2;
constexpr size_t WS_X = WS_F2 + (size_t)NE * 1024 * 2048 * 2;
constexpr size_t WS_H = WS_X + (size_t)R * D * 4;
constexpr size_t WS_YEXP = WS_H + (size_t)R * D * 2;
constexpr size_t WS_AFF = WS_YEXP + (size_t)PAIRS * D * 2;
constexpr size_t WS_SLOT = WS_AFF + (size_t)R * 16 * 4;
constexpr size_t WS_IDX = WS_SLOT + (size_t)R * 16 * 4;
constexpr size_t WS_GATE = WS_IDX + al256((size_t)PAIRS * 4);
constexpr size_t WS_U = WS_GATE + al256((size_t)PAIRS * 4);
constexpr size_t WS_HID = WS_U;
constexpr size_t WS_XG = WS_HID + (size_t)PAIRS * FF * 2;
constexpr size_t WS_O = WS_U;
constexpr size_t WS_QKV = WS_O + (size_t)R * D * 2;
constexpr size_t WS_QB = WS_QKV + (size_t)R * 1536 * 4;
constexpr size_t WS_KB = WS_QB + (size_t)R * D * 2;
constexpr size_t WS_VT = WS_KB + (size_t)NB * KVLEN * 256 * 2;
constexpr size_t WS_ATT_END = WS_VT + (size_t)NB * KVLEN * 256 * 2;
constexpr size_t WS_U1 = WS_O + (size_t)R * D * 2;
constexpr size_t WS_RKVB = WS_U1 + (size_t)4 * R * D * 4;
constexpr size_t WS_L1 = WS_RKVB + (size_t)3 * R * D * 2;
constexpr size_t WS_GB = WS_L1 + (size_t)3 * R * 128 * 2;
constexpr size_t WS_OFB = WS_GB + (size_t)R * D * 2;
constexpr size_t WS_END = WS_OFB + (size_t)2 * R * D * 4;
static_assert(WS_ATT_END <= WS_END && WS_XG + (size_t)PAIRS * D * 2 <= WS_END, "union");
static_assert(WS_END <= 2000000000ull, "workspace budget");
static_assert(WS_HID + (size_t)PAIRS * FF * 2 <= WS_END, "union");

#define XB_TMO      128
#define XB_XCNT(j)  (256  + 64 * (j))
#define XB_XSUB(j)  (1280 + 64 * (j))
#define XB_XGEN(j)  (2304 + 64 * (j))
#define XB_TOP      3328
#define XB_TOPGEN   3392
#define XCD_BAR_WORDS 3456
#define XB_SPIN_CAP (1u << 22)
#define LAS __attribute__((address_space(3)))

__device__ __forceinline__ unsigned xb_ld(unsigned* p)              { return __hip_atomic_load(p, __ATOMIC_RELAXED, __HIP_MEMORY_SCOPE_AGENT); }
__device__ __forceinline__ unsigned xb_add(unsigned* p, unsigned v) { return __hip_atomic_fetch_add(p, v, __ATOMIC_RELAXED, __HIP_MEMORY_SCOPE_AGENT); }
__device__ __forceinline__ unsigned xb_xcc_id() { return (unsigned)__builtin_amdgcn_s_getreg((3 << 11) | 20) & 0xFu; }
#define XB_SPIN(cond, bar) do { unsigned _sp = 0; while (cond) { __builtin_amdgcn_s_sleep(1); \
    if ((++_sp & 255u) == 0u) { if (xb_ld(&(bar)[XB_TMO])) break; if (_sp > XB_SPIN_CAP) { atomicAdd(&(bar)[XB_TMO], 1u); break; } } } } while (0)

struct XcdBarrier { unsigned* bar; unsigned x; volatile LAS unsigned* st; };

__device__ __forceinline__ XcdBarrier xcd_barrier_post(unsigned* bar, volatile LAS unsigned* st) {
    XcdBarrier b; b.bar = bar; b.x = xb_xcc_id(); b.st = st;
    if (threadIdx.x == 0) (void)xb_add(&bar[XB_XCNT(b.x)], 1u);
    return b;
}
__device__ __forceinline__ void xcd_barrier_complete(unsigned* bar, unsigned x, unsigned& nloc, unsigned& nx) {
    const unsigned G = gridDim.x * gridDim.y * gridDim.z;
    unsigned sum, cnt, mine, sp = 0u;
    for (;;) {
        sum = 0u; cnt = 0u; mine = 0u;
#pragma unroll
        for (unsigned j = 0; j < 16; ++j) { const unsigned c = xb_ld(&bar[XB_XCNT(j)]); sum += c; cnt += (c > 0u) ? 1u : 0u; mine = (j == x) ? c : mine; }
        if (sum == G) break;
        __builtin_amdgcn_s_sleep(1);
        if ((++sp & 255u) == 0u) { if (xb_ld(&bar[XB_TMO])) break; if (sp > XB_SPIN_CAP) { atomicAdd(&bar[XB_TMO], 1u); break; } }
    }
    nloc = mine > 0u ? mine : 1u; nx = cnt > 0u ? cnt : 1u;
}
__device__ __forceinline__ void xcd_barrier(const XcdBarrier& b) {
    asm volatile("s_waitcnt vmcnt(0)" ::: "memory");
    __syncthreads();
    if (threadIdx.x == 0) {
        unsigned* bar = b.bar;
        __builtin_amdgcn_s_waitcnt(0);
        unsigned nloc = b.st[0], nx = b.st[1];
        if (nloc == 0u) { xcd_barrier_complete(bar, b.x, nloc, nx); b.st[0] = nloc; b.st[1] = nx; }
        const unsigned old = xb_add(&bar[XB_XSUB(b.x)], 1u);
        const unsigned gen = old / nloc;
        if (old + 1u == (gen + 1u) * nloc) {
            __builtin_amdgcn_fence(__ATOMIC_RELEASE, "agent");
            asm volatile("s_waitcnt vmcnt(0)" ::: "memory");
            const unsigned og = xb_add(&bar[XB_TOP], 1u);
            const unsigned tg = og / nx;
            if (og + 1u == (tg + 1u) * nx) xb_add(&bar[XB_TOPGEN], 1u);
            else XB_SPIN(xb_ld(&bar[XB_TOPGEN]) == tg, bar);
            __builtin_amdgcn_fence(__ATOMIC_ACQUIRE, "agent");
            xb_add(&bar[XB_XGEN(b.x)], 1u);
            asm volatile("s_waitcnt vmcnt(0)" ::: "memory");
        } else {
            XB_SPIN(xb_ld(&bar[XB_XGEN(b.x)]) == gen, bar);
            __builtin_amdgcn_fence(__ATOMIC_ACQUIRE, "agent");
            asm volatile("s_waitcnt vmcnt(0)" ::: "memory");
        }
    }
    __syncthreads();
}

DEVI int tid_opaque() { int t = threadIdx.x; asm volatile("" : "+v"(t)); return t; }
#define TIDX tid_opaque()
DEVI int bid_opaque() { int t = blockIdx.x; asm volatile("" : "+s"(t)); return t; }
#define BIDX bid_opaque()
typedef float f32x2 __attribute__((ext_vector_type(2)));
typedef __bf16 bf16x2_t __attribute__((ext_vector_type(2)));
DEVI float clamp448(float v) { return __builtin_amdgcn_fmed3f(v, -448.f, 448.f); }
DEVI unsigned cvt4_fp8(float a, float b, float c, float d) { int w = 0; w = __builtin_amdgcn_cvt_pk_fp8_f32(clamp448(a), clamp448(b), w, false); w = __builtin_amdgcn_cvt_pk_fp8_f32(clamp448(c), clamp448(d), w, true); return (unsigned)w; }
DEVI unsigned cvt_pk_bf16(float lo, float hi) { const f32x2 v = {lo, hi}; const bf16x2_t b = __builtin_convertvector(v, bf16x2_t); return __builtin_bit_cast(unsigned, b); }
DEVI unsigned cvt_pk_bf16_asm(float lo, float hi) { unsigned r; asm volatile("v_cvt_pk_bf16_f32 %0, %1, %2" : "=v"(r) : "v"(lo), "v"(hi)); return r; }
DEVI bf16_t f2bf(float x) { return (bf16_t)(cvt_pk_bf16(x, 0.f) & 0xffffu); }
DEVI float bf2f(bf16_t b) { return __uint_as_float(((unsigned)b) << 16); }
DEVI float bflo(unsigned w) { return __uint_as_float(w << 16); }
DEVI float bfhi(unsigned w) { return __uint_as_float(w & 0xffff0000u); }
DEVI int crow(int r, int hi) { return (r & 3) + 8 * (r >> 2) + 4 * hi; }
DEVI float sigmoidf_(float x) { return __builtin_amdgcn_rcpf(1.f + __builtin_amdgcn_exp2f(-1.4426950408889634f * x)); }
DEVI float siluf_(float x) { return x * __builtin_amdgcn_rcpf(1.f + __builtin_amdgcn_exp2f(-1.4426950408889634f * x)); }
DEVI float tanhf_(float x) { return 1.f - 2.f * __builtin_amdgcn_rcpf(1.f + __builtin_amdgcn_exp2f(2.8853900817779268f * x)); }
DEVI float wave_sum(float v) { v += __shfl_xor(v, 32); v += __shfl_xor(v, 16); v += __shfl_xor(v, 8); v += __shfl_xor(v, 4); v += __shfl_xor(v, 2); v += __shfl_xor(v, 1); return v; }
DEVI float wave_sum_dpp(float v) {
    v += __builtin_bit_cast(float, __builtin_amdgcn_update_dpp(0, __builtin_bit_cast(int, v), 0xB1, 0xF, 0xF, true));
    v += __builtin_bit_cast(float, __builtin_amdgcn_update_dpp(0, __builtin_bit_cast(int, v), 0x4E, 0xF, 0xF, true));
    v += __builtin_bit_cast(float, __builtin_amdgcn_update_dpp(0, __builtin_bit_cast(int, v), 0x141, 0xF, 0xF, true));
    v += __builtin_bit_cast(float, __builtin_amdgcn_update_dpp(0, __builtin_bit_cast(int, v), 0x140, 0xF, 0xF, true));
    { auto r = __builtin_amdgcn_permlane16_swap(__float_as_uint(v), __float_as_uint(v), false, false); v = __uint_as_float(r[0]) + __uint_as_float(r[1]); }
    { auto r = __builtin_amdgcn_permlane32_swap(__float_as_uint(v), __float_as_uint(v), false, false); v = __uint_as_float(r[0]) + __uint_as_float(r[1]); }
    return v; }
DEVI float sum32(float v) { v += __shfl_xor(v, 16); v += __shfl_xor(v, 8); v += __shfl_xor(v, 4); v += __shfl_xor(v, 2); v += __shfl_xor(v, 1); return v; }
DEVI float sum16(float v) { v += __shfl_xor(v, 8); v += __shfl_xor(v, 4); v += __shfl_xor(v, 2); v += __shfl_xor(v, 1); return v; }
DEVI int samp_of_row(int row) { return row < RL ? (row >> 12) : 8; }

struct P {
    const float *x, *c, *ctx, *c_ctx, *mod_w, *mod_b, *a_w_qkv, *a_w_o, *a_q_norm, *a_k_norm, *b_w_qkv, *b_w_o, *b_sink,
                *c_mu, *c_w_rkv, *c_w_o, *c_w0, *c_w1, *c_w2, *c_a0, *c_a1, *c_a2, *c_g1, *c_g2, *c_k_k, *c_k_a, *c_r_k, *c_ln_w, *c_ln_b,
                *router_w, *ffn_w1, *ffn_w3, *ffn_w2, *final_norm;
    float* out; unsigned char* ws; int ph_lo, ph_hi;
};
#define WSP(type, off) ((type*)(p.ws + (off)))

constexpr float F1_MUL = 32.f, F2_MUL = 64.f; constexpr int F1_SCALE = 0x7A7A7A7A, F2_SCALE = 0x79797979;
struct CvtJob { const float* src; int ld, K, N; bf16_t* dst; int lddst, blk, bstride, off, pmode; float mul8; };
DEVI void cvt_run(const CvtJob& j, int& cursor, float* lds) {
    const int tid = TIDX, tn = j.N / 64, nt = (j.K / 64) * tn, G = gridDim.x;
    int first = ((int)BIDX - (cursor % G) + G) % G;
    for (int t = first; t < nt; t += G) {
        const int k0 = (t / tn) * 64, n0 = (t % tn) * 64;
        { const int kk = tid >> 3, c8 = (tid & 7) * 8; const float* s = j.src + (size_t)(k0 + kk) * j.ld + n0 + c8;
          const f32x4 a = *(const f32x4*)s, b = *(const f32x4*)(s + 4); float* d = lds + kk * 65 + c8;
          d[0] = a[0]; d[1] = a[1]; d[2] = a[2]; d[3] = a[3]; d[4] = b[0]; d[5] = b[1]; d[6] = b[2]; d[7] = b[3]; }
        __syncthreads();
        { const int n = tid >> 3, k8 = (tid & 7) * 8; const float* s = lds + k8 * 65 + n;
          u32x4 w = {cvt_pk_bf16(s[0], s[65]), cvt_pk_bf16(s[130], s[195]), cvt_pk_bf16(s[260], s[325]), cvt_pk_bf16(s[390], s[455])};
          const int ng = n0 + n; int nd = (ng / j.blk) * j.bstride + (ng % j.blk) + j.off;
          if (j.pmode == 1) { const int Hh = ng >> 7, dd = ng & 127, rr = dd & 63; nd = 256 * (Hh >> 1) + 128 * (dd >> 6) + 32 * (2 * (Hh & 1) + (rr >> 5)) + (rr & 31); }
          if (j.pmode == 2) { const int Hh = ng >> 6, dd = ng & 63; nd = 256 * (Hh >> 2) + 128 * (dd >> 5) + 32 * (Hh & 3) + (dd & 31); }
          if (j.mul8 != 0.f) { const float m8 = j.mul8; const u32x2 w8 = {cvt4_fp8(s[0] * m8, s[65] * m8, s[130] * m8, s[195] * m8), cvt4_fp8(s[260] * m8, s[325] * m8, s[390] * m8, s[455] * m8)};
              *(u32x2*)((unsigned char*)j.dst + (size_t)nd * j.lddst + k0 + k8) = w8; }
          else *(u32x4*)(j.dst + (size_t)nd * j.lddst + k0 + k8) = w; }
        __syncthreads();
    }
    cursor += nt;
}
DEVI CvtJob mkjob(const float* src, int K, int N, bf16_t* dst, int lddst, int off = 0, int blk = 1 << 30, int bstride = 0) { CvtJob j; j.src = src; j.ld = N; j.K = K; j.N = N; j.dst = dst; j.lddst = lddst; j.blk = blk; j.bstride = bstride; j.off = off; j.pmode = 0; j.mul8 = 0.f; return j; }

DEVI void cvt_small(const P& p, float* lds) {
    int cur = 0;
    bf16_t* wqkv = WSP(bf16_t, WS_WQKV); bf16_t* wo = WSP(bf16_t, WS_WO); bf16_t* wrkv = WSP(bf16_t, WS_WRKV); bf16_t* wl1 = WSP(bf16_t, WS_WL1); bf16_t* wl2 = WSP(bf16_t, WS_WL2);
    { CvtJob j = mkjob(p.a_w_qkv, 1024, 1536, wqkv, 1024); j.pmode = 1; j.mul8 = F1_MUL; cvt_run(j, cur, lds); }
    { CvtJob j = mkjob(p.b_w_qkv, 1024, 1536, wqkv + (size_t)1536 * 1024, 1024); j.pmode = 2; j.mul8 = F1_MUL; cvt_run(j, cur, lds); }
    { CvtJob j = mkjob(p.a_w_qkv + (size_t)1024 * 1536, 1024, 1536, wqkv + (size_t)2 * 1536 * 1024, 1024); j.pmode = 1; j.mul8 = F1_MUL; cvt_run(j, cur, lds); }
    cvt_run(mkjob(p.a_w_o, 1024, 1024, wo, 1024), cur, lds);
    cvt_run(mkjob(p.b_w_o, 1024, 1024, wo + (size_t)1 * 1024 * 1024, 1024), cur, lds);
    cvt_run(mkjob(p.c_w_o, 1024, 1024, wo + (size_t)2 * 1024 * 1024, 1024), cur, lds);
    cvt_run(mkjob(p.a_w_o + (size_t)1024 * 1024, 1024, 1024, wo + (size_t)3 * 1024 * 1024, 1024), cur, lds);
    for (int i = 0; i < 3; ++i) cvt_run(mkjob(p.c_w_rkv + (size_t)i * 1024 * 1024, 1024, 1024, wrkv + (size_t)i * 1024 * 1024, 1024), cur, lds);
    for (int d = 0; d < 2; ++d) cvt_run(mkjob(p.c_w1 + (size_t)d * 1024 * 64, 1024, 64, wl1, 1024, 64 * d), cur, lds);
    for (int d = 0; d < 2; ++d) cvt_run(mkjob(p.c_a1 + (size_t)d * 1024 * 64, 1024, 64, wl1 + (size_t)256 * 1024, 1024, 64 * d), cur, lds);
    cvt_run(mkjob(p.c_g1, 1024, 128, wl1 + (size_t)2 * 256 * 1024, 1024), cur, lds);
    for (int d = 0; d < 2; ++d) cvt_run(mkjob(p.c_w2 + (size_t)d * 64 * 1024, 64, 1024, wl2 + (size_t)(d * 1024) * 256 + 64 * d, 256), cur, lds);
    for (int d = 0; d < 2; ++d) cvt_run(mkjob(p.c_a2 + (size_t)d * 64 * 1024, 64, 1024, wl2 + (size_t)((2 + d) * 1024) * 256 + 128 + 64 * d, 256), cur, lds);
    cvt_run(mkjob(p.c_g2, 128, 1024, wl2 + (size_t)4096 * 256, 128), cur, lds);
    { const int gt = BIDX * NTHREADS + TIDX, gn = gridDim.x * NTHREADS; const u32x4 z = {0u, 0u, 0u, 0u};
      for (int i = gt; i < 3 * 128 * 128; i += gn) { const int mtx = i / (128 * 128), rm = i % (128 * 128); *(u32x4*)(wl1 + ((size_t)mtx * 256 + 128 + rm / 128) * 1024 + (rm % 128) * 8) = z; }
      for (int i = gt; i < 4096 * 32; i += gn) { const int n = i >> 5, c = i & 31; if ((c >> 3) != (n >> 10)) *(u32x4*)(wl2 + (size_t)n * 256 + c * 8) = z; } }
}
constexpr int CV_ALL = NE * 1536, CV_A = 32 * 192, CV_B = 22 * 208, CV_C = 30 * 224;
static_assert(CV_A <= NE * 1024 && CV_A + CV_B + CV_C <= CV_ALL, "conversion ranges");
DEVI void cvt_ffn(const P& p, int l, float* lds, int t0, int t1, int rank, int nblk) {
    constexpr int TB = 4;
    const int tid = TIDX, kk = tid >> 3, c8 = (tid & 7) * 8;
    unsigned char* f1 = WSP(unsigned char, WS_F1); unsigned char* f2 = WSP(unsigned char, WS_F2);
    for (int g = t0 + rank; g < t1; g += TB * nblk) {
        f32x4 a[TB], b[TB];
#pragma unroll
        for (int q = 0; q < TB; ++q) { const int gq = g + q * nblk, gc = gq < t1 ? gq : g; const float* s;
            if (gc < NE * 1024) { const int e = gc >> 10, r = gc & 1023, t = r & 511; s = ((r >> 9) ? p.ffn_w3 : p.ffn_w1) + ((size_t)l * NE + e) * 1024 * 2048 + (size_t)((t >> 5) * 64 + kk) * 2048 + (t & 31) * 64 + c8; }
            else { const int g2 = gc - NE * 1024, e = g2 >> 9, t = g2 & 511; s = p.ffn_w2 + ((size_t)l * NE + e) * 1024 * 2048 + (size_t)((t >> 4) * 64 + kk) * 1024 + (t & 15) * 64 + c8; }
            a[q] = *(const f32x4*)s; b[q] = *(const f32x4*)(s + 4); }
#pragma unroll
        for (int q = 0; q < TB; ++q) { float* d = lds + q * (64 * 65) + kk * 65 + c8;
            d[0] = a[q][0]; d[1] = a[q][1]; d[2] = a[q][2]; d[3] = a[q][3]; d[4] = b[q][0]; d[5] = b[q][1]; d[6] = b[q][2]; d[7] = b[q][3]; }
        __syncthreads();
#pragma unroll
        for (int q = 0; q < TB; ++q) { const int gq = g + q * nblk;
            if (gq < t1) { const int n = tid >> 3, k8 = (tid & 7) * 8; const float* sl = lds + q * (64 * 65) + k8 * 65 + n;
                const bool isf1 = gq < NE * 1024; const float sc = isf1 ? F1_MUL : F2_MUL;
                const u32x2 w = {cvt4_fp8(sl[0] * sc, sl[65] * sc, sl[130] * sc, sl[195] * sc), cvt4_fp8(sl[260] * sc, sl[325] * sc, sl[390] * sc, sl[455] * sc)};
                unsigned char* d;
                if (isf1) { const int e = gq >> 10, r = gq & 1023, t = r & 511, ng = (t & 31) * 64 + n, nd = (ng >> 7) * 256 + (ng & 127) + 128 * (r >> 9); d = f1 + (size_t)e * 4096 * 1024 + (size_t)nd * 1024 + (t >> 5) * 64 + k8; }
                else { const int g2 = gq - NE * 1024, e = g2 >> 9, t = g2 & 511; d = f2 + (size_t)e * 1024 * 2048 + (size_t)((t & 15) * 64 + n) * 2048 + (t >> 4) * 64 + k8; }
                *(u32x2*)d = w; } }
        __syncthreads();
    }
}
DEVI bool cv_in_tail(int part, int l) { return part == 0 ? l >= 1 : (part == 1 ? l % 3 != 2 : (part == 2 ? l != DEPTH - 1 : false)); }
DEVI int cv_lo(int part) { return part == 0 ? 0 : (part == 1 ? CV_A : (part == 2 ? CV_A + CV_B : CV_A + CV_B + CV_C)); }
DEVI int cv_hi(int part) { return part == 3 ? CV_ALL : cv_lo(part + 1); }
DEVI void cvt_ffn_norm1(const P& p, int l, float* lds) {
    for (int part = 0; part < 4; ++part) if (!cv_in_tail(part, l)) cvt_ffn(p, l, lds, cv_lo(part), cv_hi(part), (int)BIDX, (int)gridDim.x);
}
DEVI void cvt_ffn_tail(const P& p, int l, float* lds, int part, int nunits) {
    const int nbusy = nunits % (int)gridDim.x;
    if (cv_in_tail(part, l) && (int)BIDX >= nbusy) cvt_ffn(p, l, lds, cv_lo(part), cv_hi(part), (int)BIDX - nbusy, (int)gridDim.x - nbusy);
}

DEVI void ph_prologue(const P& p, float* lds) {
    const int tid = TIDX, G = gridDim.x;
    float* rope = WSP(float, WS_ROPE);
    for (int i = BIDX * NTHREADS + tid; i < 64 * 32 + 64 * 16; i += G * NTHREADS) {
        int pos, f, nf; if (i < 64 * 32) { pos = i / 32; f = i % 32; nf = 32; } else { const int j = i - 64 * 32; pos = j / 16; f = j % 16; nf = 16; }
        const float inv = (float)pow(10000.0, -(double)f / (double)nf); const float ang = (float)pos * inv;
        rope[2 * i] = (float)cos((double)ang); rope[2 * i + 1] = (float)sin((double)ang);
    }
    float* cond = lds;
    float* red = lds + 9 * 1024;
    for (int i = tid; i < 9 * 1024; i += NTHREADS) { const int s = i >> 10, k = i & 1023; const float v = s < 8 ? p.c[s * 1024 + k] : p.c_ctx[k]; cond[i] = siluf_(v); }
    __syncthreads();
    float* modv = WSP(float, WS_MODV);
    for (int item = BIDX; item < DEPTH * 96; item += G) {
        const int l = item / 96, n0 = (item % 96) * 64, cg = tid & 63, kg = tid >> 6;
        float acc[9];
#pragma unroll
        for (int s = 0; s < 9; ++s) acc[s] = 0.f;
        const float* w = p.mod_w + ((size_t)l * 1024 + kg * 128) * 6144 + n0 + cg;
        for (int k = 0; k < 128; ++k) { const float wv = w[(size_t)k * 6144];
#pragma unroll
            for (int s = 0; s < 9; ++s) acc[s] += cond[s * 1024 + kg * 128 + k] * wv; }
#pragma unroll
        for (int s = 0; s < 9; ++s) red[(kg * 9 + s) * 64 + cg] = acc[s];
        __syncthreads();
        for (int o = tid; o < 9 * 64; o += NTHREADS) { const int s = o >> 6, c = o & 63; float v = 0.f;
#pragma unroll
            for (int g = 0; g < 8; ++g) v += red[(g * 9 + s) * 64 + c];
            modv[((size_t)l * 9 + s) * 6144 + n0 + c] = v + p.mod_b[l * 6144 + n0 + c]; }
        __syncthreads();
    }
    cvt_small(p, lds);
}

constexpr size_t WS_ZROW = 40960;
DEVI float row_rinv(const f32x4 (&x)[4]) { float ss = 0.f;
#pragma unroll
    for (int i = 0; i < 4; ++i) ss += x[i][0] * x[i][0] + x[i][1] * x[i][1] + x[i][2] * x[i][2] + x[i][3] * x[i][3];
    ss = wave_sum(ss); return rsqrtf(ss * (1.f / 1024.f) + 1e-6f); }
template <bool STOREX = true, class F>
DEVI void for_rows_updated(const P& p, int l, int nrows, F&& f) {
    const int lane = TIDX & 63, gw = BIDX * NWAVES + (TIDX >> 6), nw = gridDim.x * NWAVES;
    bf16_t* Xb = WSP(bf16_t, WS_X); const int* SL = WSP(int, WS_SLOT); const bf16_t* yexp = WSP(bf16_t, WS_YEXP); const bf16_t* zrow = WSP(bf16_t, WS_ZROW);
    u32x4 xn[4]; int sn = -1;
    auto ld = [&](int row) {
        if (l == 0) { const float* src = (row < RL ? p.x + (size_t)row * D : p.ctx + (size_t)(row - RL) * D);
#pragma unroll
            for (int i = 0; i < 4; ++i) xn[i] = *(const u32x4*)(src + 4 * lane + 256 * i); }
        else {
#pragma unroll
            for (int i = 0; i < 4; ++i) { const u32x2 w = *(const u32x2*)(Xb + (size_t)row * D + 4 * lane + 256 * i); xn[i][0] = w[0]; xn[i][1] = w[1]; }
            sn = SL[(size_t)(lane & 15) * R + row]; } };
    if (gw < nrows) ld(gw);
    for (int row = gw; row < nrows; row += nw) {
        f32x4 x[4]; const int sv = sn;
#pragma unroll
        for (int i = 0; i < 4; ++i) x[i] = l == 0 ? __builtin_bit_cast(f32x4, xn[i]) : (f32x4){bflo(xn[i][0]), bfhi(xn[i][0]), bflo(xn[i][1]), bfhi(xn[i][1])};
        if (row + nw < nrows) ld(row + nw);
        f32x4 gv[4], m0[4], m1[4];
        if (l < DEPTH) { const float* mvp = WSP(float, WS_MODV) + ((size_t)l * 9 + samp_of_row(row)) * 6144 + 4 * lane;
#pragma unroll
            for (int i = 0; i < 4; ++i) { m0[i] = *(const f32x4*)(mvp + 256 * i); m1[i] = *(const f32x4*)(mvp + 1024 + 256 * i); } }
        if (l > 0) { const float* g = WSP(float, WS_MODV) + ((size_t)(l - 1) * 9 + samp_of_row(row)) * 6144 + 5 * 1024 + 4 * lane;
#pragma unroll
            for (int i = 0; i < 4; ++i) gv[i] = *(const f32x4*)(g + 256 * i); }
        if (l > 0) {
            unsigned m = (unsigned)(__ballot(sv >= 0) & 0xFFFFull);
            f32x4 acc[4];
#pragma unroll
            for (int i = 0; i < 4; ++i) acc[i] = (f32x4){0.f, 0.f, 0.f, 0.f};
            while (m) {
                const int e0 = __builtin_ctz(m); m &= m - 1; const bool two = m != 0; const int e1 = two ? __builtin_ctz(m) : 0; if (two) m &= m - 1;
                const int s0 = __builtin_amdgcn_readlane(sv, e0), s1 = __builtin_amdgcn_readlane(sv, e1);
                const bf16_t* y0 = yexp + ((size_t)e0 * EROWS + s0) * D + 4 * lane; const bf16_t* y1 = two ? yexp + ((size_t)e1 * EROWS + s1) * D + 4 * lane : zrow + 4 * lane;
                u32x2 w0[4], w1[4];
#pragma unroll
                for (int i = 0; i < 4; ++i) { w0[i] = *(const u32x2*)(y0 + 256 * i); w1[i] = *(const u32x2*)(y1 + 256 * i); }
#pragma unroll
                for (int i = 0; i < 4; ++i) { acc[i][0] += bflo(w0[i][0]) + bflo(w1[i][0]); acc[i][1] += bfhi(w0[i][0]) + bfhi(w1[i][0]); acc[i][2] += bflo(w0[i][1]) + bflo(w1[i][1]); acc[i][3] += bfhi(w0[i][1]) + bfhi(w1[i][1]); }
            }
#pragma unroll
            for (int i = 0; i < 4; ++i) x[i] = x[i] + gv[i] * acc[i];
        }
        if (STOREX && l < DEPTH) {
#pragma unroll
            for (int i = 0; i < 4; ++i) { const u32x2 w = {cvt_pk_bf16(x[i][0], x[i][1]), cvt_pk_bf16(x[i][2], x[i][3])}; *(u32x2*)(Xb + (size_t)row * D + 4 * lane + 256 * i) = w; } }
        f(row, lane, x, m0, m1);
    }
}
template <bool STOREX = true>
DEVI void ph_norm1(const P& p, int l) {
    for_rows_updated<STOREX>(p, l, R, [&](int row, int lane, const f32x4 (&x)[4], const f32x4 (&m0)[4], const f32x4 (&m1)[4]) {
        const float ri = row_rinv(x);
#pragma unroll
        for (int i = 0; i < 4; ++i) { const f32x4 sh = m0[i], sc = m1[i]; const f32x4 h = x[i] * ri * (sc + 1.f) + sh;
            if (l % 3 != 2) *(unsigned*)(WSP(unsigned char, WS_H) + (size_t)row * D + 4 * lane + 256 * i) = cvt4_fp8(h[0], h[1], h[2], h[3]);
            else { u32x2 w = {cvt_pk_bf16(h[0], h[1]), cvt_pk_bf16(h[2], h[3])}; *(u32x2*)(WSP(bf16_t, WS_H) + (size_t)row * D + 4 * lane + 256 * i) = w; } } });
}
DEVI void ph_norm2(const P& p, int l, float* lds) {
    const int tid = TIDX, lane = tid & 63, gw = BIDX * NWAVES + (tid >> 6), nw = gridDim.x * NWAVES, NR = (l == DEPTH - 1) ? RL : R;
    for (int k = tid; k < 1024; k += NTHREADS) { const f32x4* src = (const f32x4*)(p.router_w + ((size_t)l * 1024 + k) * 16); const f32x4 a = src[0], b = src[1], c = src[2], d = src[3];
        lds[0 * 1024 + k] = a[0]; lds[1 * 1024 + k] = a[1]; lds[2 * 1024 + k] = a[2]; lds[3 * 1024 + k] = a[3]; lds[4 * 1024 + k] = b[0]; lds[5 * 1024 + k] = b[1]; lds[6 * 1024 + k] = b[2]; lds[7 * 1024 + k] = b[3];
        lds[8 * 1024 + k] = c[0]; lds[9 * 1024 + k] = c[1]; lds[10 * 1024 + k] = c[2]; lds[11 * 1024 + k] = c[3]; lds[12 * 1024 + k] = d[0]; lds[13 * 1024 + k] = d[1]; lds[14 * 1024 + k] = d[2]; lds[15 * 1024 + k] = d[3]; }
    __syncthreads();
    u32x2 xn[4], xm[4];
    if (gw < NR) {
#pragma unroll
        for (int i = 0; i < 4; ++i) xn[i] = *(const u32x2*)(WSP(bf16_t, WS_X) + (size_t)gw * D + 4 * lane + 256 * i); }
    if (gw + nw < NR) {
#pragma unroll
        for (int i = 0; i < 4; ++i) xm[i] = *(const u32x2*)(WSP(bf16_t, WS_X) + (size_t)(gw + nw) * D + 4 * lane + 256 * i); }
    for (int row = gw; row < NR; row += nw) {
        f32x4 x[4];
#pragma unroll
        for (int i = 0; i < 4; ++i) { x[i] = (f32x4){bflo(xn[i][0]), bfhi(xn[i][0]), bflo(xn[i][1]), bfhi(xn[i][1])}; xn[i] = xm[i]; }
        if (row + 2 * nw < NR) {
#pragma unroll
            for (int i = 0; i < 4; ++i) xm[i] = *(const u32x2*)(WSP(bf16_t, WS_X) + (size_t)(row + 2 * nw) * D + 4 * lane + 256 * i); }
        const float ri = row_rinv(x);
        const float* mv = WSP(float, WS_MODV) + ((size_t)l * 9 + samp_of_row(row)) * 6144 + 3 * 1024 + 4 * lane;
        f32x2 lg2[16];
#pragma unroll
        for (int e = 0; e < 16; ++e) lg2[e] = (f32x2){0.f, 0.f};
        f32x4 shv[4], scv[4];
#pragma unroll
        for (int i = 0; i < 4; ++i) { shv[i] = *(const f32x4*)(mv + 256 * i); scv[i] = *(const f32x4*)(mv + 1024 + 256 * i); }
#pragma unroll
        for (int i = 0; i < 4; ++i) { const f32x4 sh = shv[i], sc = scv[i]; const f32x4 h = x[i] * ri * (sc + 1.f) + sh;
            *(unsigned*)(WSP(unsigned char, WS_H) + (size_t)row * D + 4 * lane + 256 * i) = cvt4_fp8(h[0], h[1], h[2], h[3]);
            const f32x2 h01 = {h[0], h[1]}, h23 = {h[2], h[3]};
#pragma unroll
            for (int e = 0; e < 16; ++e) { const f32x4 wv = *(const f32x4*)(lds + e * 1024 + 4 * lane + 256 * i); lg2[e] = lg2[e] + h01 * (f32x2){wv[0], wv[1]} + h23 * (f32x2){wv[2], wv[3]}; }
            asm volatile("" ::: "memory"); }
#define DPPF(x, ctrl) __builtin_bit_cast(float, __builtin_amdgcn_update_dpp(0, __builtin_bit_cast(int, x), ctrl, 0xF, 0xF, true))
        float s1[8], s2[4]; const bool p0 = lane & 1, p1 = lane & 2;
#pragma unroll
        for (int k = 0; k < 8; ++k) { const float a = lg2[2 * k][0] + lg2[2 * k][1], b = lg2[2 * k + 1][0] + lg2[2 * k + 1][1]; const float send = p0 ? a : b, keep = p0 ? b : a; s1[k] = keep + DPPF(send, 0xB1); }
#pragma unroll
        for (int m = 0; m < 4; ++m) { const float send = p1 ? s1[2 * m] : s1[2 * m + 1], keep = p1 ? s1[2 * m + 1] : s1[2 * m]; float v = keep + DPPF(send, 0x4E);
            v += DPPF(v, 0x124); v += DPPF(v, 0x128);
            { auto r = __builtin_amdgcn_permlane16_swap(__float_as_uint(v), __float_as_uint(v), false, false); v = __uint_as_float(r[0]) + __uint_as_float(r[1]); }
            { auto r = __builtin_amdgcn_permlane32_swap(__float_as_uint(v), __float_as_uint(v), false, false); v = __uint_as_float(r[0]) + __uint_as_float(r[1]); }
            s2[m] = v; }
        float mx = fmaxf(fmaxf(s2[0], s2[1]), fmaxf(s2[2], s2[3])); mx = fmaxf(mx, DPPF(mx, 0xB1)); mx = fmaxf(mx, DPPF(mx, 0x4E));
        float ex[4], se = 0.f;
#pragma unroll
        for (int m = 0; m < 4; ++m) { ex[m] = __builtin_amdgcn_exp2f((s2[m] - mx) * 1.4426950408889634f); se += ex[m]; }
        se += DPPF(se, 0xB1); se += DPPF(se, 0x4E);
#undef DPPF
        if (lane < 4) { const float inv = 1.f / se;
#pragma unroll
            for (int m = 0; m < 4; ++m) WSP(float, WS_AFF)[(size_t)row * 16 + 4 * m + lane] = ex[m] * inv; }
    }
    __syncthreads();
}
DEVI void ph_final(const P& p) {
    for_rows_updated(p, DEPTH, RL, [&](int row, int lane, const f32x4 (&x)[4], const f32x4 (&)[4], const f32x4 (&)[4]) {
        const float ri = row_rinv(x);
#pragma unroll
        for (int i = 0; i < 4; ++i) *(f32x4*)(p.out + (size_t)row * D + 4 * lane + 256 * i) = x[i] * ri * *(const f32x4*)(p.final_norm + 4 * lane + 256 * i); });
}

template <class Epi>
DEVI void gemm_wave_tile(const bf16_t* __restrict__ A, int lda, const int* __restrict__ gidx, const bf16_t* __restrict__ Bt, int ldb, int K, int m0, int n0, int noff, const Epi& epi, int orow0) {
    const int lane = TIDX & 63, r32 = lane & 31, hi = lane >> 5;
    const size_t ra0 = gidx ? (size_t)gidx[m0 + r32] : (size_t)(m0 + r32), ra1 = gidx ? (size_t)gidx[m0 + 32 + r32] : (size_t)(m0 + 32 + r32);
    const bf16_t* a0p = A + ra0 * lda + hi * 8; const bf16_t* a1p = A + ra1 * lda + hi * 8;
    const bf16_t* b0p = Bt + (size_t)(n0 + r32) * ldb + hi * 8; const bf16_t* b1p = Bt + (size_t)(n0 + noff + r32) * ldb + hi * 8;
    f32x16 c00 = {}, c01 = {}, c10 = {}, c11 = {};
    for (int k = 0; k < K; k += 16) {
        const bf16x8 a0 = *(const bf16x8*)(a0p + k), a1 = *(const bf16x8*)(a1p + k), b0 = *(const bf16x8*)(b0p + k), b1 = *(const bf16x8*)(b1p + k);
        c00 = __builtin_amdgcn_mfma_f32_32x32x16_bf16(a0, b0, c00, 0, 0, 0); c01 = __builtin_amdgcn_mfma_f32_32x32x16_bf16(a0, b1, c01, 0, 0, 0);
        c10 = __builtin_amdgcn_mfma_f32_32x32x16_bf16(a1, b0, c10, 0, 0, 0); c11 = __builtin_amdgcn_mfma_f32_32x32x16_bf16(a1, b1, c11, 0, 0, 0);
    }
#pragma unroll
    for (int r = 0; r < 16; ++r) { const int rr = crow(r, hi);
        if constexpr (Epi::PAIRED) { epi.pair(orow0 + m0 + rr, n0 + r32, c00[r], c01[r]); epi.pair(orow0 + m0 + 32 + rr, n0 + r32, c10[r], c11[r]); }
        else { epi(orow0 + m0 + rr, n0 + r32, c00[r]); epi(orow0 + m0 + rr, n0 + noff + r32, c01[r]); epi(orow0 + m0 + 32 + rr, n0 + r32, c10[r]); epi(orow0 + m0 + 32 + rr, n0 + noff + r32, c11[r]); } }
}
template <class Epi>
DEVI void gemm_all(const bf16_t* A, int lda, const bf16_t* Bt, int ldb, int M, int N, int K, const Epi& epi, int& cur) {
    const int gw = BIDX * NWAVES + (TIDX >> 6), nw = gridDim.x * NWAVES, tn = N / 64, nt = (M / 64) * tn;
    const int first = (gw - (cur % nw) + nw) % nw;
    for (int t = first; t < nt; t += nw) gemm_wave_tile(A, lda, nullptr, Bt, ldb, K, (t / tn) * 64, (t % tn) * 64, 32, epi, 0);
    cur += nt;
}

struct EpiF32 { static constexpr bool PAIRED = false; float* C; int ldc; DEVI void operator()(int row, int col, float v) const { C[(size_t)row * ldc + col] = v; } };
template <int ACT> struct EpiBf16 { static constexpr bool PAIRED = false; bf16_t* C; int ldc;
    DEVI void operator()(int row, int col, float v) const { if (ACT == 1) v = tanhf_(v); if (ACT == 2) v = sigmoidf_(v); C[(size_t)row * ldc + col] = f2bf(v); } };
struct EpiResid { static constexpr bool PAIRED = false; float* X; const float* gate;
    DEVI void operator()(int row, int col, float v) const { float* x = X + (size_t)row * D + col; *x += gate[(size_t)samp_of_row(row) * 6144 + col] * v; } };
struct EpiSwiGLU { static constexpr bool PAIRED = true; bf16_t* H;
    DEVI void pair(int row, int ncol, float g, float u) const { const int hc = (ncol >> 8) * 128 + (ncol & 255); H[(size_t)row * FF + hc] = f2bf(siluf_(g) * u); } };
struct EpiGate { static constexpr bool PAIRED = false; bf16_t* Y; const float* gate;
    DEVI void operator()(int row, int col, float v) const { Y[(size_t)row * D + col] = f2bf(gate[row] * v); } };
struct EpiDecay { static constexpr bool PAIRED = false; float* W; const float* w0;
    DEVI void operator()(int row, int col, float v) const { W[(size_t)row * D + col] = __expf(-0.6065306597126334f * sigmoidf_(w0[col] + v)); } };
struct EpiSig { static constexpr bool PAIRED = false; float* W; const float* a0;
    DEVI void operator()(int row, int col, float v) const { W[(size_t)row * D + col] = sigmoidf_(a0[col] + v); } };

namespace g8 {
constexpr int BM = 256, BK = 64, HALF = 128, HTB = HALF * BK * 2, STAGE_BYTES = 8 * HTB;
DEVI int lds_byte(int r, int c) { const int st = (r >> 4) * 2 + (c >> 5), rr = r & 15, cc = c & 31, ob = rr * 64 + cc * 2; return st * 1024 + (ob ^ (((ob >> 9) & 1) << 5)); }
DEVI void stage_rc(int b, int& Rr, int& Cc) { const int st = b / 1024, sb = b % 1024, swz = sb ^ (((sb >> 9) & 1) << 5); Rr = (st >> 1) * 16 + swz / 64; Cc = (st & 1) * 32 + (swz % 64) / 2; }
DEVI int perm32(int rho) { const int n = rho >> 4, i = rho & 15; return 8 * (i >> 2) + 4 * n + (i & 3); }
struct Unit { const char* A; const char* B; const int* gidx; int pm, pn, e; };
DEVI float ld_f32_uncounted(const float* p) { float v; asm volatile("global_load_dword %0, %1, off" : "=v"(v) : "v"(p) : "memory"); return v; }
DEVI int ld_i32_uncounted(const int* p) { int v; asm volatile("global_load_dword %0, %1, off" : "=v"(v) : "v"(p) : "memory"); return v; }
DEVI const char* uptr(const char* p) { const unsigned long long v = (unsigned long long)p; const unsigned lo = __builtin_amdgcn_readfirstlane((unsigned)v), hi = __builtin_amdgcn_readfirstlane((unsigned)(v >> 32)); return (const char*)(((unsigned long long)hi << 32) | lo); }
template <class Epi, class Sched, bool GATHER = false, bool F8 = false>
DEVI void gemm_phase(LAS unsigned char* lds, const int K, const Sched& S, const Epi& E, const int wscale = 0x7F7F7F7F) {
    const int tid = TIDX, wid = __builtin_amdgcn_readfirstlane(tid >> 6), lane = tid & 63, wr = wid >> 2, wc = wid & 3, fr = lane & 15, fq = lane >> 4;
    const int nt = K / BK;
    unsigned voffB[2]; int rowA[2], colA[2];
#pragma unroll
    for (int i = 0; i < 2; ++i) { int Rr, Cc; stage_rc(tid * 16 + i * 8192, Rr, Cc); const int Rb = Epi::PERM ? ((Rr & ~31) + perm32(Rr & 31)) : Rr;
        rowA[i] = Rr; colA[i] = Cc; voffB[i] = (unsigned)(Rb * K + Cc) * 2u; }
    const size_t kstep = (size_t)(BK * 2), hstep = (size_t)HALF * K * 2;
    unsigned oc[2][2], on[2][2]; int ri[2][2];
#define G8_AOFF(dst, u) do { _Pragma("unroll") for (int _h = 0; _h < 2; ++_h) _Pragma("unroll") for (int _i = 0; _i < 2; ++_i) \
        dst[_h][_i] = (unsigned)((GATHER ? (u).gidx[_h * HALF + rowA[_i]] : (_h * HALF + rowA[_i])) * K + colA[_i]) * 2u; } while (0)
    const unsigned ldsw = (unsigned)wid * 1024u;
    const int aoff = lds_byte(wr * 64 + fr, fq * 8), boff = lds_byte(wc * 32 + fr, fq * 8);
#define G8_SA(b, h) (((b) * 2 + (h)) * HTB)
#define G8_SB(b, h) ((4 + (b) * 2 + (h)) * HTB)
#define G8_STAGE(bufoff, gbase, voff) do { _Pragma("unroll") for (int _i = 0; _i < 2; ++_i) \
        __builtin_amdgcn_global_load_lds((const unsigned*)((const char*)(gbase) + (voff)[_i]), (LAS unsigned*)(lds + (bufoff) + ldsw + _i * 8192), 16, 0, 0); } while (0)
#define G8_LDA(dst, b, h) do { _Pragma("unroll") for (int m = 0; m < 4; ++m) _Pragma("unroll") for (int k = 0; k < 2; ++k) dst[m][k] = *(const LAS bf16x8*)(lds + G8_SA(b, h) + aoff + m * 2048 + k * 1024); } while (0)
#define G8_LDB(dst, b, h) do { _Pragma("unroll") for (int n = 0; n < 2; ++n) _Pragma("unroll") for (int k = 0; k < 2; ++k) dst[n][k] = *(const LAS bf16x8*)(lds + G8_SB(b, h) + boff + n * 2048 + k * 1024); } while (0)
#define G8_CAT(v) __builtin_shufflevector(__builtin_bit_cast(i32x4, v[0]), __builtin_bit_cast(i32x4, v[1]), 0, 1, 2, 3, 4, 5, 6, 7)
#define G8_MMA(ai, bj, At, Bt) do { __builtin_amdgcn_s_setprio(1); \
        if constexpr (F8) { _Pragma("unroll") for (int m = 0; m < 4; ++m) _Pragma("unroll") for (int n = 0; n < 2; ++n) \
            asm volatile("v_mfma_scale_f32_16x16x128_f8f6f4 %0, %1, %2, %0, %3, %4 op_sel_hi:[0,0,0]" : "+v"(acc[ai][bj][m][n]) : "v"(G8_CAT(Bt[n])), "v"(G8_CAT(At[m])), "v"(wsc), "v"(one)); } \
        else { _Pragma("unroll") for (int m = 0; m < 4; ++m) _Pragma("unroll") for (int n = 0; n < 2; ++n) _Pragma("unroll") for (int k = 0; k < 2; ++k) \
            acc[ai][bj][m][n] = __builtin_amdgcn_mfma_f32_16x16x32_bf16(Bt[n][k], At[m][k], acc[ai][bj][m][n], 0, 0, 0); } \
        __builtin_amdgcn_s_setprio(0); } while (0)
#define G8_WAIT_V(n) asm volatile("s_waitcnt vmcnt(" #n ")" ::: "memory")
#define G8_WAIT_L(n) asm volatile("s_waitcnt lgkmcnt(" #n ")" ::: "memory")
#define G8_BAR __builtin_amdgcn_s_barrier()
#define G8_SCHED __builtin_amdgcn_sched_barrier(0)
    Unit cur, nxt; int ui = 0;
    if (!S.next(0, cur)) return;
    f32x4 acc[2][2][4][2];
#pragma unroll
    for (int a = 0; a < 2; ++a)
#pragma unroll
        for (int b = 0; b < 2; ++b)
#pragma unroll
            for (int m = 0; m < 4; ++m)
#pragma unroll
                for (int n = 0; n < 2; ++n) acc[a][b][m][n] = (f32x4){0.f, 0.f, 0.f, 0.f};
    bf16x8 At[4][2], B0[2][2], B1[2][2];
    int wsc = wscale, one = 0x7F7F7F7F; asm volatile("" : "+v"(wsc), "+v"(one));
    const char* cA = uptr(cur.A); const char* cB = uptr(cur.B);
    G8_AOFF(oc, cur);
    G8_STAGE(G8_SB(0, 0), cB, voffB); G8_STAGE(G8_SA(0, 0), cA, oc[0]); G8_STAGE(G8_SB(0, 1), cB + hstep, voffB); G8_STAGE(G8_SA(0, 1), cA, oc[1]);
    if (wr == 1) G8_BAR;
    G8_WAIT_V(4); G8_BAR;
    G8_STAGE(G8_SB(1, 0), cB + kstep, voffB); G8_STAGE(G8_SA(1, 0), cA + kstep, oc[0]); G8_STAGE(G8_SB(1, 1), cB + hstep + kstep, voffB);
    G8_WAIT_V(6); G8_BAR;
    for (;;) {
        const bool has_next = S.next(ui + 1, nxt);
        float pfv[8]; if constexpr (Epi::HAS_PRE) E.pre(cur, wr, wc, fr, fq, pfv);
        const char* nA = uptr(has_next ? nxt.A : cA); const char* nB = uptr(has_next ? nxt.B : cB);
        if (GATHER) { const int* ng = has_next ? nxt.gidx : cur.gidx;
            _Pragma("unroll") for (int _h = 0; _h < 2; ++_h) _Pragma("unroll") for (int _i = 0; _i < 2; ++_i) ri[_h][_i] = ld_i32_uncounted(ng + _h * HALF + rowA[_i]); }
#pragma unroll 1
        for (int t = 0; t < nt; t += 2) {
            const bool last = (t == nt - 2);
            const char* a1 = cA + (size_t)(t + 1) * kstep;
            const char* a2 = last ? nA : cA + (size_t)(t + 2) * kstep; const char* b2 = last ? nB : cB + (size_t)(t + 2) * kstep;
            const char* a3 = a2 + kstep; const char* b3 = b2 + kstep;
            unsigned o2[2][2];
            if constexpr (GATHER) {
                if (last) { _Pragma("unroll") for (int _h = 0; _h < 2; ++_h) _Pragma("unroll") for (int _i = 0; _i < 2; ++_i) { int _rv = ri[_h][_i]; asm volatile("" : "+v"(_rv)); on[_h][_i] = (unsigned)(_rv * K + colA[_i]) * 2u; } }
                _Pragma("unroll") for (int _h = 0; _h < 2; ++_h) _Pragma("unroll") for (int _i = 0; _i < 2; ++_i) o2[_h][_i] = last ? on[_h][_i] : oc[_h][_i];
            } else { _Pragma("unroll") for (int _h = 0; _h < 2; ++_h) _Pragma("unroll") for (int _i = 0; _i < 2; ++_i) o2[_h][_i] = oc[_h][_i]; }
            G8_LDB(B0, 0, 0); G8_SCHED; G8_LDA(At, 0, 0); G8_STAGE(G8_SA(1, 1), a1, oc[1]);
            G8_WAIT_L(8); G8_BAR; G8_WAIT_L(0); G8_MMA(0, 0, At, B0); G8_BAR; G8_SCHED;
            G8_LDB(B1, 0, 1); G8_STAGE(G8_SB(0, 0), b2, voffB);
            G8_BAR; G8_WAIT_L(0); G8_MMA(0, 1, At, B1); G8_BAR;
            G8_LDA(At, 0, 1); G8_STAGE(G8_SA(0, 0), a2, o2[0]);
            G8_BAR; G8_WAIT_L(0); G8_MMA(1, 0, At, B0); G8_BAR; G8_SCHED;
            G8_STAGE(G8_SB(0, 1), b2 + hstep, voffB);
            G8_WAIT_V(6); G8_BAR; G8_MMA(1, 1, At, B1); G8_BAR;
            G8_LDB(B0, 1, 0); G8_SCHED; G8_LDA(At, 1, 0); G8_STAGE(G8_SA(0, 1), a2, o2[1]);
            G8_WAIT_L(8); G8_BAR; G8_WAIT_L(0); G8_MMA(0, 0, At, B0); G8_BAR; G8_SCHED;
            G8_LDB(B1, 1, 1); G8_STAGE(G8_SB(1, 0), b3, voffB);
            G8_BAR; G8_WAIT_L(0); G8_MMA(0, 1, At, B1); G8_BAR;
            G8_LDA(At, 1, 1); G8_STAGE(G8_SA(1, 0), a3, o2[0]);
            G8_BAR; G8_WAIT_L(0); G8_MMA(1, 0, At, B0); G8_BAR; G8_SCHED;
            G8_STAGE(G8_SB(1, 1), b3 + hstep, voffB);
            G8_WAIT_V(6); G8_BAR; G8_MMA(1, 1, At, B1); G8_BAR;
        }
        if constexpr (F8) asm volatile("s_nop 15\n\ts_nop 15" ::: "memory");
        if constexpr (Epi::HAS_PRE) E(acc, cur, wr, wc, fr, fq, pfv); else E(acc, cur, wr, wc, fr, fq);
        if (!has_next) break;
#pragma unroll
        for (int a = 0; a < 2; ++a)
#pragma unroll
            for (int b = 0; b < 2; ++b)
#pragma unroll
                for (int m = 0; m < 4; ++m)
#pragma unroll
                    for (int n = 0; n < 2; ++n) acc[a][b][m][n] = (f32x4){0.f, 0.f, 0.f, 0.f};
        cur = nxt; cA = nA; cB = nB; ++ui;
        if constexpr (GATHER) { _Pragma("unroll") for (int _h = 0; _h < 2; ++_h) _Pragma("unroll") for (int _i = 0; _i < 2; ++_i) oc[_h][_i] = on[_h][_i]; }
    }
    G8_WAIT_V(0);
    if (wr == 0) G8_BAR;
    G8_BAR;
#undef G8_AOFF
#undef G8_SA
#undef G8_SB
#undef G8_STAGE
#undef G8_LDA
#undef G8_LDB
#undef G8_MMA
#undef G8_CAT
#undef G8_WAIT_V
#undef G8_WAIT_L
#undef G8_BAR
#undef G8_SCHED
}
DEVI int xcd_remap(int L, int n) { const int q = n / 8, r = n % 8, x = L % 8, off = L / 8; return (x < r ? x * (q + 1) : r * (q + 1) + (x - r) * q) + off; }
struct PlainOrder {
    const char *A, *B; size_t sA, sB; int ng, nM, nN, K;
    DEVI bool next(int i, Unit& u) const { const int n = ng * nM * nN; const long L = (long)i * gridDim.x + BIDX; if (L >= n) return false;
        const int id = xcd_remap((int)L, n), per = nM * nN, g = id / per, rm = id % per; u.pm = rm / nN; u.pn = rm % nN; u.e = g;
        u.A = A + (size_t)g * sA + (size_t)u.pm * 256 * K * 2; u.B = B + (size_t)g * sB + (size_t)u.pn * 256 * K * 2; u.gidx = nullptr; return true; }
};
struct ExpertOrder {
    const char* A; const char* B; const int* gidx; size_t bstride; int nM, nN, K, mstride;
    DEVI bool next(int i, Unit& u) const { const int n = NE * nM * nN; const long L = (long)i * gridDim.x + BIDX; if (L >= n) return false;
        const int id = xcd_remap((int)L, n), per = nM * nN, e = id / per, rm = id % per; u.e = e; u.pm = e * mstride + rm / nN; u.pn = rm % nN;
        u.gidx = gidx ? gidx + (size_t)u.pm * 256 : nullptr; u.A = gidx ? A : A + (size_t)u.pm * 256 * K * 2; u.B = B + (size_t)e * bstride + (size_t)u.pn * 256 * K * 2; return true; }
};
struct EpiF32 { static constexpr bool HAS_PRE = false, PERM = false; float* C; int ldc;
    DEVI void operator()(const f32x4 (&acc)[2][2][4][2], const Unit& u, int wr, int wc, int fr, int fq) const {
        float* base = C + (size_t)(u.pm * 256 + wr * 64 + fr) * ldc + u.pn * 256 + wc * 32 + 4 * fq;
#pragma unroll
        for (int ai = 0; ai < 2; ++ai)
#pragma unroll
            for (int m = 0; m < 4; ++m) { float* rp = base + (size_t)(ai * 128 + m * 16) * ldc;
#pragma unroll
                for (int bj = 0; bj < 2; ++bj)
#pragma unroll
                    for (int n = 0; n < 2; ++n) *(f32x4*)(rp + bj * 128 + n * 16) = acc[ai][bj][m][n]; } } };
struct EpiNull { static constexpr bool HAS_PRE = false, PERM = true; float* sink;
    DEVI void operator()(const f32x4 (&acc)[2][2][4][2], const Unit& u, int wr, int wc, int fr, int fq) const {
        float t = 0.f;
#pragma unroll
        for (int ai = 0; ai < 2; ++ai)
#pragma unroll
            for (int bj = 0; bj < 2; ++bj)
#pragma unroll
                for (int m = 0; m < 4; ++m)
#pragma unroll
                    for (int n = 0; n < 2; ++n) t += acc[ai][bj][m][n][0];
        if (t == 1.2345e30f) sink[0] = t; } };
DEVI u32x4 pack8(const f32x4 a, const f32x4 b) { return (u32x4){cvt_pk_bf16(a[0], a[1]), cvt_pk_bf16(a[2], a[3]), cvt_pk_bf16(b[0], b[1]), cvt_pk_bf16(b[2], b[3])}; }
struct EpiResid { static constexpr bool HAS_PRE = false, PERM = true; bf16_t* X; const float* gate;
    DEVI void operator()(const f32x4 (&acc)[2][2][4][2], const Unit& u, int wr, int wc, int fr, int fq) const {
        const int col0 = u.pn * 256 + wc * 32 + 8 * fq; const float* g = gate + (size_t)samp_of_row(u.pm * 256) * 6144 + col0;
        f32x4 gv[2][2];
#pragma unroll
        for (int bj = 0; bj < 2; ++bj)
#pragma unroll
            for (int n = 0; n < 2; ++n) gv[bj][n] = *(const f32x4*)(g + bj * 128 + n * 4);
        bf16_t* base = X + (size_t)(u.pm * 256 + wr * 64 + fr) * D + col0;
#pragma unroll
        for (int ai = 0; ai < 2; ++ai) { u32x4 xv[4][2];
#pragma unroll
            for (int m = 0; m < 4; ++m)
#pragma unroll
                for (int bj = 0; bj < 2; ++bj) xv[m][bj] = *(const u32x4*)(base + (size_t)(ai * 128 + m * 16) * D + bj * 128);
            __builtin_amdgcn_sched_barrier(0);
#pragma unroll
            for (int m = 0; m < 4; ++m)
#pragma unroll
                for (int bj = 0; bj < 2; ++bj) { const u32x4 w = xv[m][bj];
                    const f32x4 lo = (f32x4){bflo(w[0]), bfhi(w[0]), bflo(w[1]), bfhi(w[1])} + gv[bj][0] * acc[ai][bj][m][0], hi = (f32x4){bflo(w[2]), bfhi(w[2]), bflo(w[3]), bfhi(w[3])} + gv[bj][1] * acc[ai][bj][m][1];
                    *(u32x4*)(base + (size_t)(ai * 128 + m * 16) * D + bj * 128) = pack8(lo, hi); }
            __builtin_amdgcn_sched_barrier(0); } } };
struct EpiBf16 { static constexpr bool HAS_PRE = false, PERM = true; bf16_t* C; size_t sC; int ldc;
    DEVI void operator()(const f32x4 (&acc)[2][2][4][2], const Unit& u, int wr, int wc, int fr, int fq) const {
        bf16_t* c = C + (size_t)u.e * sC;
        bf16_t* base = c + (size_t)(u.pm * 256 + wr * 64 + fr) * ldc + u.pn * 256 + wc * 32 + 8 * fq;
#pragma unroll
        for (int ai = 0; ai < 2; ++ai)
#pragma unroll
            for (int m = 0; m < 4; ++m) { bf16_t* rp = base + (size_t)(ai * 128 + m * 16) * ldc;
#pragma unroll
                for (int bj = 0; bj < 2; ++bj) *(u32x4*)(rp + bj * 128) = pack8(acc[ai][bj][m][0], acc[ai][bj][m][1]); } } };
struct EpiSwiGLU { static constexpr bool HAS_PRE = false, PERM = true; unsigned char* H;
    DEVI void operator()(const f32x4 (&acc)[2][2][4][2], const Unit& u, int wr, int wc, int fr, int fq) const {
        unsigned char* base = H + (size_t)(u.pm * 256 + wr * 64 + fr) * FF + u.pn * 128 + wc * 32 + 8 * fq;
#pragma unroll
        for (int ai = 0; ai < 2; ++ai)
#pragma unroll
            for (int m = 0; m < 4; ++m) { f32x4 h[2];
#pragma unroll
                for (int n = 0; n < 2; ++n)
#pragma unroll
                    for (int j = 0; j < 4; ++j) h[n][j] = siluf_(acc[ai][0][m][n][j]) * acc[ai][1][m][n][j];
                *(u32x2*)(base + (size_t)(ai * 128 + m * 16) * FF) = (u32x2){cvt4_fp8(h[0][0], h[0][1], h[0][2], h[0][3]), cvt4_fp8(h[1][0], h[1][1], h[1][2], h[1][3])}; } } };
struct EpiGate { static constexpr bool HAS_PRE = true, PERM = true; bf16_t* Y; const float* gate;
    DEVI void pre(const Unit& u, int wr, int wc, int fr, int fq, float (&pf)[8]) const { const int row0 = u.pm * 256 + wr * 64 + fr;
#pragma unroll
        for (int ai = 0; ai < 2; ++ai)
#pragma unroll
            for (int m = 0; m < 4; ++m) pf[ai * 4 + m] = ld_f32_uncounted(gate + row0 + ai * 128 + m * 16); }
    DEVI void operator()(const f32x4 (&acc)[2][2][4][2], const Unit& u, int wr, int wc, int fr, int fq, const float (&pf)[8]) const {
        const int row0 = u.pm * 256 + wr * 64 + fr; bf16_t* base = Y + (size_t)row0 * D + u.pn * 256 + wc * 32 + 8 * fq;
#pragma unroll
        for (int ai = 0; ai < 2; ++ai)
#pragma unroll
            for (int m = 0; m < 4; ++m) { const float gv = pf[ai * 4 + m]; bf16_t* rp = base + (size_t)(ai * 128 + m * 16) * D;
#pragma unroll
                for (int bj = 0; bj < 2; ++bj) *(u32x4*)(rp + bj * 128) = pack8(acc[ai][bj][m][0] * gv, acc[ai][bj][m][1] * gv); } } };
DEVI float xsum_fq(float v) {
    { auto r = __builtin_amdgcn_permlane16_swap(__float_as_uint(v), __float_as_uint(v), false, false); v = __uint_as_float(r[0]) + __uint_as_float(r[1]); }
    { auto r = __builtin_amdgcn_permlane32_swap(__float_as_uint(v), __float_as_uint(v), false, false); v = __uint_as_float(r[0]) + __uint_as_float(r[1]); }
    return v; }
DEVI void row_pos(int row, bool& lat, int& b, int& pos, int& prow, int& pcol) { lat = row < RL; int tt; if (lat) { b = row >> 12; tt = row & 4095; pos = tt; } else { const int rc = row - RL; b = rc >> 8; tt = rc & 255; pos = T + tt; } prow = tt >> 6; pcol = tt & 63; }
DEVI void st4(bf16_t* p, const f32x4 v) { *(u32x2*)p = (u32x2){cvt_pk_bf16(v[0], v[1]), cvt_pk_bf16(v[2], v[3])}; }
struct EpiQKV0 { static constexpr bool HAS_PRE = false, PERM = false; bf16_t *Q, *K, *V; const float *qn, *kn, *rope; LAS float* xch;
    DEVI void operator()(const f32x4 (&acc)[2][2][4][2], const Unit& u, int wr, int wc, int fr, int fq) const {
        const int wave = wr * 4 + wc; const bool isv = u.pn == 5, isk = u.pn == 4;
        int frx = fr; asm volatile("" : "+v"(frx));
        float ps[2][4];
#pragma unroll
        for (int ai = 0; ai < 2; ++ai)
#pragma unroll
            for (int m = 0; m < 4; ++m) { float sq = 0.f;
#pragma unroll
                for (int bj = 0; bj < 2; ++bj)
#pragma unroll
                    for (int n = 0; n < 2; ++n) { const f32x4 v = acc[ai][bj][m][n]; sq += v[0] * v[0] + v[1] * v[1] + v[2] * v[2] + v[3] * v[3]; }
                ps[ai][m] = xsum_fq(sq); }
        if (fq == 0) {
#pragma unroll
            for (int ai = 0; ai < 2; ++ai)
#pragma unroll
                for (int m = 0; m < 4; ++m) xch[wave * 128 + ai * 64 + m * 16 + frx] = ps[ai][m]; }
        asm volatile("s_waitcnt lgkmcnt(0)" ::: "memory"); __builtin_amdgcn_s_barrier(); asm volatile("" ::: "memory");
#pragma unroll
        for (int ai = 0; ai < 2; ++ai)
#pragma unroll
            for (int m = 0; m < 4; ++m) ps[ai][m] = isv ? 1.f : rsqrtf((ps[ai][m] + xch[(wave ^ 1) * 128 + ai * 64 + m * 16 + frx]) * (1.f / 128.f) + 1e-6f);
        const int dlo = 32 * (wc & 1) + 4 * fq;
        f32x4 g[2][2];
#pragma unroll
        for (int bj = 0; bj < 2; ++bj)
#pragma unroll
            for (int n = 0; n < 2; ++n) g[bj][n] = isv ? (f32x4){1.f, 1.f, 1.f, 1.f} : *(const f32x4*)((isk ? kn : qn) + 64 * bj + dlo + 16 * n);
        const int hcol = (isk || isv ? (wc >> 1) : (2 * u.pn + (wc >> 1))) * 128 + dlo;
        const bool latT = u.pm * 256 < RL, colw = wc & 1;
#pragma unroll
        for (int mh = 0; mh < 2; ++mh) { f32x4 tab[2][2][2];
            if (latT && !isv) {
#pragma unroll
                for (int q = 0; q < 2; ++q) { const int tt0 = (u.pm * 256 + q * 128 + wr * 64) & 4095; const int pp = colw ? (16 * (2 * mh + q) + fr) : (tt0 >> 6); const float* rt = rope + (size_t)(pp * 32 + 4 * fq) * 2;
#pragma unroll
                    for (int n = 0; n < 2; ++n) { tab[q][n][0] = *(const f32x4*)(rt + 32 * n); tab[q][n][1] = *(const f32x4*)(rt + 32 * n + 4); } } }
#pragma unroll
            for (int ai = 0; ai < 2; ++ai)
#pragma unroll
                for (int mm = 0; mm < 2; ++mm) { const int m = 2 * mh + mm; const int row = u.pm * 256 + ai * 128 + wr * 64 + m * 16 + fr; bool lat; int b, pos, prow, pcol; row_pos(row, lat, b, pos, prow, pcol);
                    bf16_t* dst = Q + (size_t)row * D + hcol; unsigned char* d8 = (unsigned char*)(isk ? K : V) + ((size_t)b * KVLEN + pos) * 256 + hcol;
#pragma unroll
                    for (int n = 0; n < 2; ++n) { f32x4 x1 = acc[ai][0][m][n] * ps[ai][m] * g[0][n], x2 = acc[ai][1][m][n] * ps[ai][m] * g[1][n];
                        if (latT && !isv) { const f32x4 c0 = colw ? tab[mm][n][0] : tab[ai][n][0], c1 = colw ? tab[mm][n][1] : tab[ai][n][1];
                            const f32x4 cs = {c0[0], c0[2], c1[0], c1[2]}, sn = {c0[1], c0[3], c1[1], c1[3]}; const f32x4 y1 = x1 * cs - x2 * sn, y2 = x1 * sn + x2 * cs; x1 = y1; x2 = y2; }
                        if (isk || isv) { *(unsigned*)(d8 + 16 * n) = cvt4_fp8(x1[0], x1[1], x1[2], x1[3]); *(unsigned*)(d8 + 64 + 16 * n) = cvt4_fp8(x2[0], x2[1], x2[2], x2[3]); }
                        else { st4(dst + 16 * n, x1); st4(dst + 64 + 16 * n, x2); } } }
            __builtin_amdgcn_sched_barrier(0); }
    } };
struct EpiQKV1 { static constexpr bool HAS_PRE = false, PERM = false; bf16_t *Q, *K, *V; const float* rope;
    DEVI void operator()(const f32x4 (&acc)[2][2][4][2], const Unit& u, int wr, int wc, int fr, int fq) const {
        const bool isv = u.pn == 5, isk = u.pn == 4; const int hcol = (isk || isv ? wc : 4 * u.pn + wc) * 64 + 4 * fq;
        const bool latT = u.pm * 256 < RL; f32x4 tr[2][2], tc[4][2];
        if (latT && !isv) {
#pragma unroll
            for (int ai = 0; ai < 2; ++ai) { const int prow = ((u.pm * 256 + ai * 128 + wr * 64) & 4095) >> 6; const float* rt = rope + (size_t)(prow * 16 + 4 * fq) * 2; tr[ai][0] = *(const f32x4*)rt; tr[ai][1] = *(const f32x4*)(rt + 4); }
#pragma unroll
            for (int m = 0; m < 4; ++m) { const float* rt = rope + (size_t)((16 * m + fr) * 16 + 4 * fq) * 2; tc[m][0] = *(const f32x4*)rt; tc[m][1] = *(const f32x4*)(rt + 4); } }
#pragma unroll
        for (int ai = 0; ai < 2; ++ai)
#pragma unroll
            for (int m = 0; m < 4; ++m) { const int row = u.pm * 256 + ai * 128 + wr * 64 + m * 16 + fr; bool lat; int b, pos, prow, pcol; row_pos(row, lat, b, pos, prow, pcol);
                bf16_t* dst = Q + (size_t)row * D + hcol; unsigned char* d8 = (unsigned char*)(isk ? K : V) + ((size_t)b * KVLEN + pos) * 256 + hcol;
#pragma unroll
                for (int n = 0; n < 2; ++n) { f32x4 x1 = acc[ai][0][m][n], x2 = acc[ai][1][m][n];
                    if (latT && !isv) { const f32x4 c0 = n ? tc[m][0] : tr[ai][0], c1 = n ? tc[m][1] : tr[ai][1];
                        const f32x4 cs = {c0[0], c0[2], c1[0], c1[2]}, sn = {c0[1], c0[3], c1[1], c1[3]}; const f32x4 y1 = x1 * cs - x2 * sn, y2 = x1 * sn + x2 * cs; x1 = y1; x2 = y2; }
                    if (isk || isv) { *(unsigned*)(d8 + 16 * n) = cvt4_fp8(x1[0], x1[1], x1[2], x1[3]); *(unsigned*)(d8 + 32 + 16 * n) = cvt4_fp8(x2[0], x2[1], x2[2], x2[3]); }
                    else { st4(dst + 16 * n, x1); st4(dst + 32 + 16 * n, x2); } } }
    } };
struct G1Order { const char *A, *B, *BL; size_t sA; int nM;
    DEVI bool next(int i, Unit& u) const { const int n = 3 * nM * 4 + 3 * nM; const long L = (long)i * gridDim.x + BIDX; if (L >= n) return false;
        const int id = xcd_remap((int)L, n); int g, pm, pn; const char* b;
        if (id < 3 * nM * 4) { g = id / (nM * 4); const int rm = id % (nM * 4); pm = rm >> 2; pn = rm & 3; b = B + (size_t)g * 1024 * 1024 * 2 + (size_t)pn * 256 * 1024 * 2; }
        else { const int j = id - 3 * nM * 4; g = 3 + j / nM; pm = j % nM; pn = 0; b = BL + (size_t)(g - 3) * 256 * 1024 * 2; }
        u.e = g; u.pm = pm; u.pn = pn; u.gidx = nullptr; u.A = A + (size_t)g * sA + (size_t)pm * 256 * 1024 * 2; u.B = b; return true; }
};
struct EpiG1 { static constexpr bool HAS_PRE = false, PERM = true; bf16_t* RKV; size_t sC; bf16_t *L1WA, *L1G;
    DEVI void operator()(const f32x4 (&acc)[2][2][4][2], const Unit& u, int wr, int wc, int fr, int fq) const {
        const int row0 = u.pm * 256 + wr * 64 + fr, c0 = wc * 32 + 8 * fq;
        if (u.e < 3) { bf16_t* base = RKV + (size_t)u.e * sC + (size_t)row0 * D + u.pn * 256 + c0;
#pragma unroll
            for (int ai = 0; ai < 2; ++ai)
#pragma unroll
                for (int m = 0; m < 4; ++m) { bf16_t* rp = base + (size_t)(ai * 128 + m * 16) * D;
#pragma unroll
                    for (int bj = 0; bj < 2; ++bj) *(u32x4*)(rp + bj * 128) = pack8(acc[ai][bj][m][0], acc[ai][bj][m][1]); } }
        else { bf16_t* base = u.e == 5 ? L1G + (size_t)row0 * 128 + c0 : L1WA + (size_t)row0 * 256 + (u.e == 4 ? 128 : 0) + c0; const int ld = u.e == 5 ? 128 : 256;
#pragma unroll
            for (int ai = 0; ai < 2; ++ai)
#pragma unroll
                for (int m = 0; m < 4; ++m) { f32x4 v0 = acc[ai][0][m][0], v1 = acc[ai][0][m][1];
                    if (u.e == 3) {
#pragma unroll
                        for (int j = 0; j < 4; ++j) { v0[j] = tanhf_(v0[j]); v1[j] = tanhf_(v1[j]); } }
                    if (u.e == 5) {
#pragma unroll
                        for (int j = 0; j < 4; ++j) { v0[j] = sigmoidf_(v0[j]); v1[j] = sigmoidf_(v1[j]); } }
                    *(u32x4*)(base + (size_t)(ai * 128 + m * 16) * ld) = pack8(v0, v1); } }
    } };
struct EpiWA { static constexpr bool HAS_PRE = false, PERM = false; bf16_t* W; size_t sW; bf16_t* AB; const float *w0, *a0;
    template <bool DEC> DEVI void run(const f32x4 (&acc)[2][2][4][2], const float* bias, bf16_t* baseb) const {
        f32x4 bvv[2][2];
#pragma unroll
        for (int bj = 0; bj < 2; ++bj)
#pragma unroll
            for (int n = 0; n < 2; ++n) bvv[bj][n] = *(const f32x4*)(bias + bj * 128 + n * 16);
#pragma unroll
        for (int bj = 0; bj < 2; ++bj)
#pragma unroll
            for (int n = 0; n < 2; ++n) { const f32x4 bv = bvv[bj][n];
#pragma unroll
                for (int ai = 0; ai < 2; ++ai)
#pragma unroll
                    for (int m = 0; m < 4; ++m) { f32x4 v = acc[ai][bj][m][n] + bv;
#pragma unroll
                        for (int j = 0; j < 4; ++j) { const float sg = sigmoidf_(v[j]); v[j] = DEC ? 0.8750387749145276f * sg : sg; }
                        st4(baseb + (size_t)(ai * 128 + m * 16) * D + bj * 128 + n * 16, v);
                        __builtin_amdgcn_sched_barrier(0); } } }
    DEVI void operator()(const f32x4 (&acc)[2][2][4][2], const Unit& u, int wr, int wc, int fr, int fq) const {
        const int q = u.pn >> 2, lc0 = (u.pn & 3) * 256 + wc * 32 + 4 * fq; const size_t ro = (size_t)(u.pm * 256 + wr * 64 + fr) * D + lc0;
        if (q < 2) run<true>(acc, w0 + (q & 1) * 1024 + lc0, W + (size_t)q * sW + ro); else run<false>(acc, a0 + (q & 1) * 1024 + lc0, AB + (size_t)(q & 1) * sW + ro);
    } };
}
#define G8LDS ((LAS unsigned char*)(shm + 1024))

DEVI int wq_slot(int l) { return l == 0 ? 0 : (l == 1 ? 1 : 2); }
DEVI void ph_qkv_gemm(const P& p, int l) {
    g8::PlainOrder S{}; S.A = (const char*)WSP(bf16_t, WS_H); S.B = (const char*)(WSP(bf16_t, WS_WQKV) + (size_t)wq_slot(l) * 1536 * 1024); S.ng = 1; S.nM = R / 256; S.nN = 6; S.K = 512;
    if (l % 3 == 0) { g8::EpiQKV0 e{WSP(bf16_t, WS_QB), WSP(bf16_t, WS_KB), WSP(bf16_t, WS_VT), p.a_q_norm + (l / 3) * 128, p.a_k_norm + (l / 3) * 128, WSP(float, WS_ROPE), (LAS float*)(shm + 1024 + g8::STAGE_BYTES)}; g8::gemm_phase<g8::EpiQKV0, g8::PlainOrder, false, true>(G8LDS, 512, S, e, F1_SCALE); }
    else { g8::EpiQKV1 e{WSP(bf16_t, WS_QB), WSP(bf16_t, WS_KB), WSP(bf16_t, WS_VT), WSP(float, WS_ROPE) + 64 * 32 * 2}; g8::gemm_phase<g8::EpiQKV1, g8::PlainOrder, false, true>(G8LDS, 512, S, e, F1_SCALE); } }

DEVI void ph_qkv_post(const P& p, int l) {
    const int kind = l % 3, j = l / 3, lane = TIDX & 63, gw = BIDX * NWAVES + (TIDX >> 6), nw = gridDim.x * NWAVES;
    const float* qkv = WSP(float, WS_QKV); bf16_t* Qb = WSP(bf16_t, WS_QB); bf16_t* Kb = WSP(bf16_t, WS_KB); bf16_t* Vt = WSP(bf16_t, WS_VT);
    const float* rope = WSP(float, WS_ROPE) + (kind == 0 ? 0 : 64 * 32 * 2);
    for (int row = gw; row < R; row += nw) {
        const bool lat = row < RL; int b, pos, tt; if (lat) { b = row >> 12; tt = row & 4095; pos = tt; } else { const int rc = row - RL; b = rc >> 8; tt = rc & 255; pos = T + tt; }
        const int prow = tt >> 6, pcol = tt & 63;
        f32x4 vin[6];
#pragma unroll
        for (int ch = 0; ch < 6; ++ch) vin[ch] = *(const f32x4*)(qkv + (size_t)row * 1536 + ch * 256 + 4 * lane);
#pragma unroll
        for (int ch = 0; ch < 6; ++ch) {
            f32x4 v = vin[ch];
            if (ch < 5) {
                if (kind == 0) {
                    const float ss = sum32(v[0] * v[0] + v[1] * v[1] + v[2] * v[2] + v[3] * v[3]); const float ri = rsqrtf(ss * (1.f / 128.f) + 1e-6f);
                    const float* gn = (ch < 4 ? p.a_q_norm : p.a_k_norm) + j * 128 + 4 * (lane & 31);
                    v = v * ri * *(const f32x4*)gn;
                    if (lat) { f32x4 o; o[0] = __shfl_xor(v[0], 16); o[1] = __shfl_xor(v[1], 16); o[2] = __shfl_xor(v[2], 16); o[3] = __shfl_xor(v[3], 16);
                        const bool second = (lane & 16) != 0;
#pragma unroll
                        for (int q = 0; q < 4; ++q) { const int pi = 4 * (lane & 15) + q; const int pp = pi < 32 ? prow : pcol, f = pi & 31; const float cs = rope[(pp * 32 + f) * 2], sn = rope[(pp * 32 + f) * 2 + 1];
                            v[q] = second ? (o[q] * sn + v[q] * cs) : (v[q] * cs - o[q] * sn); } }
                } else {
                    if (lat) { f32x4 o; o[0] = __shfl_xor(v[0], 8); o[1] = __shfl_xor(v[1], 8); o[2] = __shfl_xor(v[2], 8); o[3] = __shfl_xor(v[3], 8);
                        const bool second = (lane & 8) != 0;
#pragma unroll
                        for (int q = 0; q < 4; ++q) { const int pi = 4 * (lane & 7) + q; const int pp = pi < 16 ? prow : pcol, f = pi & 15; const float cs = rope[(pp * 16 + f) * 2], sn = rope[(pp * 16 + f) * 2 + 1];
                            v[q] = second ? (o[q] * sn + v[q] * cs) : (v[q] * cs - o[q] * sn); } }
                }
                u32x2 w = {cvt_pk_bf16(v[0], v[1]), cvt_pk_bf16(v[2], v[3])};
                if (ch < 4) *(u32x2*)(Qb + (size_t)row * D + ch * 256 + 4 * lane) = w;
                else *(u32x2*)(Kb + ((size_t)b * KVLEN + pos) * 256 + 4 * lane) = w;
            } else {
                { u32x2 w = {cvt_pk_bf16(v[0], v[1]), cvt_pk_bf16(v[2], v[3])}; *(u32x2*)(Vt + ((size_t)b * KVLEN + pos) * 256 + 4 * lane) = w; }
            }
        }
    }
}

namespace a128 {
constexpr int DH = 128, QBLK = 32, KVBLK = 64, LDQ = 1024, LDK = 256, LDO = 1024;
constexpr float SCALE = 0.088388347648318440f, THR = 5.f;
constexpr size_t SHM_V = KVBLK * DH * 2, SHM_K = KVBLK * DH * 2, SHM_ATTN = 2 * SHM_V + 2 * SHM_K + NWAVES * 64 * 4;
#define KSWZ(row, colB) ((row) * 256 + ((colB) ^ (((row) & 7) << 4)))
#define SBAR() __builtin_amdgcn_sched_barrier(0)
DEVI void partialSM(f32x16& p0, f32x16& p1, float& m_reg, float& mn, float& alpha) {
  constexpr float C = SCALE * 1.4426950408889634f;
  float pmax = p0[0]; for (int r = 1; r < 16; ++r) pmax = fmaxf(pmax, p0[r]); for (int r = 0; r < 16; ++r) pmax = fmaxf(pmax, p1[r]);
  { auto rr = __builtin_amdgcn_permlane32_swap(__float_as_uint(pmax), __float_as_uint(pmax), false, false);
    pmax = fmaxf(__uint_as_float(rr[0]), __uint_as_float(rr[1])); }
  if (__builtin_expect(__all(pmax - m_reg <= THR / SCALE), 1)) { mn = m_reg; alpha = 1.f; }
  else { mn = fmaxf(m_reg, pmax); alpha = __builtin_amdgcn_exp2f((m_reg - mn) * C); m_reg = mn; }
  float mnC = 1.f - mn * C;
  for (int r = 0; r < 16; ++r) p0[r] = fmaf(p0[r], C, mnC); for (int r = 0; r < 16; ++r) p1[r] = fmaf(p1[r], C, mnC);
  for (int r = 0; r < 16; ++r) p0[r] = __builtin_amdgcn_exp2f(p0[r]);
}
DEVI void finishSM(f32x16& p0, f32x16& p1, float alpha, float& l_reg, bf16x8& pa0, bf16x8& pa1, bf16x8& pa2, bf16x8& pa3) {
  for (int r = 0; r < 16; ++r) p1[r] = __builtin_amdgcn_exp2f(p1[r]);
  float ps = 0; for (int r = 0; r < 16; ++r) ps += p0[r]; for (int r = 0; r < 16; ++r) ps += p1[r];
  { auto rr = __builtin_amdgcn_permlane32_swap(__float_as_uint(ps), __float_as_uint(ps), false, false);
    ps = __uint_as_float(rr[0]) + __uint_as_float(rr[1]); }
  l_reg = l_reg * alpha + ps;
#define PK4(Pv, BASE, OUT) do { unsigned a0 = cvt_pk_bf16_asm(Pv[BASE + 0], Pv[BASE + 1]), a1 = cvt_pk_bf16_asm(Pv[BASE + 2], Pv[BASE + 3]);   \
    unsigned b0 = cvt_pk_bf16_asm(Pv[BASE + 4], Pv[BASE + 5]), b1 = cvt_pk_bf16_asm(Pv[BASE + 6], Pv[BASE + 7]);                              \
    auto r0 = __builtin_amdgcn_permlane32_swap(a0, b0, false, false); auto r1 = __builtin_amdgcn_permlane32_swap(a1, b1, false, false); \
    u32x4 w = {r0[0], r1[0], r0[1], r1[1]}; OUT = *reinterpret_cast<bf16x8*>(&w); } while (0)
  PK4(p0, 0, pa0); PK4(p0, 8, pa1); PK4(p1, 0, pa2); PK4(p1, 8, pa3);
#undef PK4
}
#define KSWZ8(row, colB) ((row) * 128 + ((colB) ^ ((((row) >> 1) & 7) << 4)))
DEVI void qkt(f32x16& p0, f32x16& p1, const char* Ks, const i32x8* q8, int r32, int hi) {
  p0 = f32x16{}; p1 = f32x16{};
#pragma unroll
  for (int s = 0; s < 2; ++s) { const int cb = 64 * s + 32 * hi;
    const i32x4 a0 = *reinterpret_cast<const i32x4*>(Ks + KSWZ8(r32, cb)), a1 = *reinterpret_cast<const i32x4*>(Ks + KSWZ8(r32, cb + 16));
    const i32x4 b0 = *reinterpret_cast<const i32x4*>(Ks + KSWZ8(32 + r32, cb)), b1 = *reinterpret_cast<const i32x4*>(Ks + KSWZ8(32 + r32, cb + 16));
    p0 = __builtin_amdgcn_mfma_scale_f32_32x32x64_f8f6f4(__builtin_shufflevector(a0, a1, 0, 1, 2, 3, 4, 5, 6, 7), q8[s], p0, 0, 0, 0, 0x7F7F7F7F, 0, 0x7F7F7F7F);
    p1 = __builtin_amdgcn_mfma_scale_f32_32x32x64_f8f6f4(__builtin_shufflevector(b0, b1, 0, 1, 2, 3, 4, 5, 6, 7), q8[s], p1, 0, 0, 0, 0x7F7F7F7F, 0, 0x7F7F7F7F); }
}
DEVI u32x2 k8pack(const bf16x8 v) { const u32x4 w = __builtin_bit_cast(u32x4, v); return (u32x2){cvt4_fp8(bflo(w[0]), bfhi(w[0]), bflo(w[1]), bfhi(w[1])), cvt4_fp8(bflo(w[2]), bfhi(w[2]), bflo(w[3]), bfhi(w[3]))}; }
DEVI int v_st(int k, int c) { const int kk = (k & ~0xC) | ((k & 4) << 1) | ((k & 8) >> 1); return ((kk >> 3) * 4 + (c >> 5)) * 512 + ((kk & 7) * 32 + (c & 31)) * 2; }
DEVI int v_rd_base(int lane) { return ((lane & 3) << 3) | (((lane >> 2) & 3) << 6) | (((lane >> 4) & 1) << 5) | (((lane >> 5) & 1) << 8); }
constexpr int v_rd_off(int d0, int ks, int half) { return d0 * 512 + ks * 4096 + half * 2048; }
template <int OFF> DEVI s16x4 tr_read(int vb) { s16x4 r; asm volatile("ds_read_b64_tr_b16 %0, %1 offset:%2" : "=&v"(r) : "v"(vb), "i"(OFF) : "memory"); return r; }
template <int D0> DEVI void pv_one(f32x16& od, int vb, bf16x8 pa0, bf16x8 pa1, bf16x8 pa2, bf16x8 pa3) {
  const s16x4 l0 = tr_read<v_rd_off(D0, 0, 0)>(vb), h0 = tr_read<v_rd_off(D0, 0, 1)>(vb), l1 = tr_read<v_rd_off(D0, 1, 0)>(vb), h1 = tr_read<v_rd_off(D0, 1, 1)>(vb);
  const s16x4 l2 = tr_read<v_rd_off(D0, 2, 0)>(vb), h2 = tr_read<v_rd_off(D0, 2, 1)>(vb), l3 = tr_read<v_rd_off(D0, 3, 0)>(vb), h3 = tr_read<v_rd_off(D0, 3, 1)>(vb);
  asm volatile("s_waitcnt lgkmcnt(0)" ::: "memory"); SBAR();
#define PK(L, H) (bf16x8){L[0], L[1], L[2], L[3], H[0], H[1], H[2], H[3]}
  od = __builtin_amdgcn_mfma_f32_32x32x16_bf16(pa0, PK(l0, h0), od, 0, 0, 0);
  od = __builtin_amdgcn_mfma_f32_32x32x16_bf16(pa1, PK(l1, h1), od, 0, 0, 0);
  od = __builtin_amdgcn_mfma_f32_32x32x16_bf16(pa2, PK(l2, h2), od, 0, 0, 0);
  od = __builtin_amdgcn_mfma_f32_32x32x16_bf16(pa3, PK(l3, h3), od, 0, 0, 0);
#undef PK
}
DEVI void pv_d0(f32x16* o, int vb, bf16x8 pa0, bf16x8 pa1, bf16x8 pa2, bf16x8 pa3) {
  pv_one<0>(o[0], vb, pa0, pa1, pa2, pa3); pv_one<1>(o[1], vb, pa0, pa1, pa2, pa3); pv_one<2>(o[2], vb, pa0, pa1, pa2, pa3); pv_one<3>(o[3], vb, pa0, pa1, pa2, pa3);
}
DEVI unsigned p4(const f32x16& p, int b) { int w = 0; w = __builtin_amdgcn_cvt_pk_fp8_f32(p[b], p[b + 1], w, false); w = __builtin_amdgcn_cvt_pk_fp8_f32(p[b + 2], p[b + 3], w, true); return (unsigned)w; }
DEVI void finishSM8(f32x16& p0, f32x16& p1, float alpha, float& l_reg, i32x8& pa) {
  for (int r = 0; r < 16; ++r) p1[r] = __builtin_amdgcn_exp2f(p1[r]);
  (void)alpha; (void)l_reg;
  const auto r0 = __builtin_amdgcn_permlane32_swap(p4(p0, 0), p4(p0, 8), false, false), t0 = __builtin_amdgcn_permlane32_swap(p4(p0, 4), p4(p0, 12), false, false);
  const auto r1 = __builtin_amdgcn_permlane32_swap(p4(p1, 0), p4(p1, 8), false, false), t1 = __builtin_amdgcn_permlane32_swap(p4(p1, 4), p4(p1, 12), false, false);
  pa = (i32x8){(int)r0[0], (int)r0[1], (int)t0[0], (int)t0[1], (int)r1[0], (int)r1[1], (int)t1[0], (int)t1[1]};
}
template <int D0> DEVI void pv_one8(f32x16& od, int vb, const i32x8 pa) {
  const s16x4 l0 = tr_read<v_rd_off(D0, 0, 0)>(vb), h0 = tr_read<v_rd_off(D0, 0, 1)>(vb), l1 = tr_read<v_rd_off(D0, 1, 0)>(vb), h1 = tr_read<v_rd_off(D0, 1, 1)>(vb);
  asm volatile("s_waitcnt lgkmcnt(0)" ::: "memory"); SBAR();
  typedef int i32x2_ __attribute__((ext_vector_type(2)));
  const i32x2_ a = __builtin_bit_cast(i32x2_, l0), b = __builtin_bit_cast(i32x2_, h0), c = __builtin_bit_cast(i32x2_, l1), d = __builtin_bit_cast(i32x2_, h1);
  od = __builtin_amdgcn_mfma_scale_f32_32x32x64_f8f6f4(pa, (i32x8){a[0], a[1], b[0], b[1], c[0], c[1], d[0], d[1]}, od, 0, 0, 0, 0x7F7F7F7F, 0, 0x7F7F7F7F);
}
DEVI void pv_d08(f32x16* o, f32x16& ls, int vb, const i32x8 pa) { pv_one8<0>(o[0], vb, pa); pv_one8<1>(o[1], vb, pa); pv_one8<2>(o[2], vb, pa); pv_one8<3>(o[3], vb, pa);
  const int one4 = 0x38383838; ls = __builtin_amdgcn_mfma_scale_f32_32x32x64_f8f6f4(pa, (i32x8){one4, one4, one4, one4, one4, one4, one4, one4}, ls, 0, 0, 0, 0x7F7F7F7F, 0, 0x7F7F7F7F); }
DEVI u32x2 k8raw(const bf16x8 v) { const u32x4 w = __builtin_bit_cast(u32x4, v); int x = 0, y = 0;
  x = __builtin_amdgcn_cvt_pk_fp8_f32(bflo(w[0]), bfhi(w[0]), x, false); x = __builtin_amdgcn_cvt_pk_fp8_f32(bflo(w[1]), bfhi(w[1]), x, true);
  y = __builtin_amdgcn_cvt_pk_fp8_f32(bflo(w[2]), bfhi(w[2]), y, false); y = __builtin_amdgcn_cvt_pk_fp8_f32(bflo(w[3]), bfhi(w[3]), y, true); return (u32x2){(unsigned)x, (unsigned)y}; }
DEVI void body(const bf16_t* __restrict__ Qb, const unsigned char* __restrict__ Kh, const unsigned char* __restrict__ Vh, bf16_t* __restrict__ Ob, int seq, LAS char* ldsl) {
  const int tid = TIDX, wid = tid >> 6, lane = tid & 63, r32 = lane & 31, hi = lane >> 5;
  char* lds = (char*)ldsl;
  char* V_lds = lds; char* K_lds = lds + 2 * SHM_V;
  float* ws = (float*)(lds + 2 * SHM_V + 2 * SHM_K) + wid * 64; float* li_l = ws; float* al_l = ws + 32;
  float m_reg = -1e30f, l_reg = 0; f32x16 o[4] = {}; f32x16 ls = {}; i32x8 qr[2];
  const bf16_t* Qw = Qb + (long)(wid * QBLK + r32) * LDQ + hi * 32;
#pragma unroll
  for (int s = 0; s < 2; ++s) { bf16x8 qv[4];
#pragma unroll
    for (int c = 0; c < 4; ++c) qv[c] = *(const bf16x8*)(Qw + s * 64 + c * 8);
    const u32x2 c0 = k8pack(qv[0]), c1 = k8pack(qv[1]), c2 = k8pack(qv[2]), c3 = k8pack(qv[3]);
    qr[s] = (i32x8){(int)c0[0], (int)c0[1], (int)c1[0], (int)c1[1], (int)c2[0], (int)c2[1], (int)c3[0], (int)c3[1]}; }
  const int sr = tid >> 4, sc = (tid & 15) * 8, vst0 = v_st(sr, sc), vst1 = v_st(32 + sr, sc);
  const int vb0 = (int)(uintptr_t)ldsl + v_rd_base(lane);
  struct { u32x2 vs0, vs1, ks0, ks1; } sr_[2];
  const unsigned loff0 = (unsigned)(sr * LDK + sc), loff1 = loff0 + 32u * LDK, lvf0 = (unsigned)(2 * sr * LDK + sc), lvf1 = lvf0 + LDK;
#define SLOAD(i, k0) do { const char* _vb = (const char*)Vh + (size_t)(k0) * LDK; const char* _kb = (const char*)Kh + (size_t)(k0) * LDK; \
    sr_[i].vs0 = *(const u32x2*)(_vb + lvf0); sr_[i].vs1 = *(const u32x2*)(_vb + lvf1); sr_[i].ks0 = *(const u32x2*)(_kb + loff0); sr_[i].ks1 = *(const u32x2*)(_kb + loff1); } while (0)
#define SWRITE(b, i) do { const u32x2 _e = sr_[i].vs0, _o = sr_[i].vs1;    \
    *(u32x4*)(V_lds + (b) * SHM_V + vst0) = (u32x4){__builtin_amdgcn_perm(_o[0], _e[0], 0x05010400u), __builtin_amdgcn_perm(_o[0], _e[0], 0x07030602u), __builtin_amdgcn_perm(_o[1], _e[1], 0x05010400u), __builtin_amdgcn_perm(_o[1], _e[1], 0x07030602u)}; \
    *(u32x2*)(K_lds + (b) * SHM_K + KSWZ8(sr, sc)) = sr_[i].ks0;                \
    *(u32x2*)(K_lds + (b) * SHM_K + KSWZ8(32 + sr, sc)) = sr_[i].ks1; } while (0)
#define SWAIT() asm volatile("s_waitcnt vmcnt(4)" ::: "memory")
#define RESC(a) do { if (__any((a) < 1.f)) { if (hi == 0) al_l[r32] = (a); asm volatile("s_waitcnt lgkmcnt(0)" ::: "memory"); \
    for (int r = 0; r < 16; ++r) { const float _al = al_l[crow(r, hi)]; ls[r] *= _al; for (int d = 0; d < 4; ++d) o[d][r] *= _al; } } } while (0)
  f32x16 pA0, pA1, pB0, pB1; float mnA, mnB, alA, alB; i32x8 pa8; const int NT = seq / KVBLK;
  constexpr int SE = 0, SO = 1;
  SLOAD(SE, 0); asm volatile("s_waitcnt vmcnt(0)" ::: "memory"); SWRITE(0, SE); __syncthreads();
  qkt(pA0, pA1, K_lds, qr, r32, hi); partialSM(pA0, pA1, m_reg, mnA, alA);
  SLOAD(SO, KVBLK); if (2 < NT) SLOAD(SE, 2 * KVBLK);
  SWAIT(); SWRITE(1, SO); __syncthreads();
  for (int j = 1; j + 1 < NT; j += 2) {
    SBAR(); qkt(pB0, pB1, K_lds + SHM_K, qr, r32, hi);
    finishSM8(pA0, pA1, alA, l_reg, pa8); SBAR();
    SLOAD(SO, (j + 2) * KVBLK); SBAR();
    pv_d08(o, ls, vb0, pa8); partialSM(pB0, pB1, m_reg, mnB, alB);
    __syncthreads(); SWAIT(); SWRITE(0, SE);
    RESC(alB); __syncthreads();
    SBAR(); qkt(pA0, pA1, K_lds, qr, r32, hi);
    finishSM8(pB0, pB1, alB, l_reg, pa8); SBAR();
    if (j + 3 < NT) SLOAD(SE, (j + 3) * KVBLK); SBAR();
    pv_d08(o, ls, vb0 + (int)SHM_V, pa8); partialSM(pA0, pA1, m_reg, mnA, alA);
    __syncthreads(); SWAIT(); SWRITE(1, SO);
    RESC(alA); __syncthreads();
  }
  SBAR(); qkt(pB0, pB1, K_lds + SHM_K, qr, r32, hi);
  finishSM8(pA0, pA1, alA, l_reg, pa8); SBAR();
  pv_d08(o, ls, vb0, pa8); partialSM(pB0, pB1, m_reg, mnB, alB);
  __syncthreads(); RESC(alB);
  finishSM8(pB0, pB1, alB, l_reg, pa8); SBAR();
  pv_d08(o, ls, vb0 + (int)SHM_V, pa8);
  float rli[16];
#pragma unroll
  for (int r = 0; r < 16; ++r) rli[r] = __builtin_amdgcn_rcpf(ls[r]);
  bf16_t* Ow = Ob + (long)(wid * QBLK) * LDO;
#pragma unroll
  for (int r = 0; r < 16; ++r) { int orow = crow(r, hi);
    for (int d0 = 0; d0 < 4; ++d0) Ow[(long)orow * LDO + d0 * 32 + r32] = f2bf(o[d0][r] * rli[r]); }
#undef SLOAD
#undef SWRITE
#undef SWAIT
#undef RESC
}
}
namespace a64 {
constexpr int DH = 64, QBLK = 32, KVBLK = 64, LDQ = 1024, LDK = 256, LDO = 1024;
constexpr float SCALE = 0.125f, THR = 5.f;
constexpr size_t SHM_V = KVBLK * DH * 2, SHM_K = KVBLK * DH * 2;
#define KSWZ64(row, colB) ((row) * 128 + ((colB) ^ (((row) & 7) << 4)))
DEVI void partialSM(f32x16& p0, f32x16& p1, float& m_reg, float& mn, float& alpha, bool masked, int dq0  ) {
  constexpr float C = SCALE * 1.4426950408889634f;
  if (masked) {
    for (int r = 0; r < 16; ++r) { const int dq = dq0 + (r & 3) + 8 * (r >> 2); if (dq > 128 || dq < -128) p0[r] = -1e30f; const int d2 = dq + 32; if (d2 > 128 || d2 < -128) p1[r] = -1e30f; } }
  float pmax = p0[0]; for (int r = 1; r < 16; ++r) pmax = fmaxf(pmax, p0[r]); for (int r = 0; r < 16; ++r) pmax = fmaxf(pmax, p1[r]);
  { auto rr = __builtin_amdgcn_permlane32_swap(__float_as_uint(pmax), __float_as_uint(pmax), false, false);
    pmax = fmaxf(__uint_as_float(rr[0]), __uint_as_float(rr[1])); }
  if (__builtin_expect(__all(pmax - m_reg <= THR / SCALE), 1)) { mn = m_reg; alpha = 1.f; }
  else { mn = fmaxf(m_reg, pmax); alpha = __builtin_amdgcn_exp2f((m_reg - mn) * C); m_reg = mn; }
  float mnC = 1.f - mn * C;
  for (int r = 0; r < 16; ++r) p0[r] = fmaf(p0[r], C, mnC); for (int r = 0; r < 16; ++r) p1[r] = fmaf(p1[r], C, mnC);
  for (int r = 0; r < 16; ++r) p0[r] = __builtin_amdgcn_exp2f(p0[r]);
}
#define KSWZ4(row, colB) ((row) * 64 + ((colB) ^ ((((row) >> 2) & 3) << 4)))
DEVI void qkt(f32x16& p0, f32x16& p1, const char* Ks, const i32x8 q8, int r32, int hi) {
  const int cb = 32 * hi; const f32x16 z = {};
  const i32x4 a0 = *reinterpret_cast<const i32x4*>(Ks + KSWZ4(r32, cb)), a1 = *reinterpret_cast<const i32x4*>(Ks + KSWZ4(r32, cb + 16));
  const i32x4 b0 = *reinterpret_cast<const i32x4*>(Ks + KSWZ4(32 + r32, cb)), b1 = *reinterpret_cast<const i32x4*>(Ks + KSWZ4(32 + r32, cb + 16));
  p0 = __builtin_amdgcn_mfma_scale_f32_32x32x64_f8f6f4(__builtin_shufflevector(a0, a1, 0, 1, 2, 3, 4, 5, 6, 7), q8, z, 0, 0, 0, 0x7F7F7F7F, 0, 0x7F7F7F7F);
  p1 = __builtin_amdgcn_mfma_scale_f32_32x32x64_f8f6f4(__builtin_shufflevector(b0, b1, 0, 1, 2, 3, 4, 5, 6, 7), q8, z, 0, 0, 0, 0x7F7F7F7F, 0, 0x7F7F7F7F);
}
DEVI int v_st(int k, int c) { const int kk = (k & ~0xC) | ((k & 4) << 1) | ((k & 8) >> 1); return ((kk >> 3) * 2 + (c >> 5)) * 512 + ((kk & 7) * 32 + (c & 31)) * 2; }
constexpr int v_rd_off(int d0, int ks, int half) { return d0 * 512 + ks * 2048 + half * 1024; }
template <int D0> DEVI void pv_one(f32x16& od, int vb, bf16x8 pa0, bf16x8 pa1, bf16x8 pa2, bf16x8 pa3) {
  using a128::tr_read;
  const s16x4 l0 = tr_read<v_rd_off(D0, 0, 0)>(vb), h0 = tr_read<v_rd_off(D0, 0, 1)>(vb), l1 = tr_read<v_rd_off(D0, 1, 0)>(vb), h1 = tr_read<v_rd_off(D0, 1, 1)>(vb);
  const s16x4 l2 = tr_read<v_rd_off(D0, 2, 0)>(vb), h2 = tr_read<v_rd_off(D0, 2, 1)>(vb), l3 = tr_read<v_rd_off(D0, 3, 0)>(vb), h3 = tr_read<v_rd_off(D0, 3, 1)>(vb);
  asm volatile("s_waitcnt lgkmcnt(0)" ::: "memory"); SBAR();
#define PK(L, H) (bf16x8){L[0], L[1], L[2], L[3], H[0], H[1], H[2], H[3]}
  od = __builtin_amdgcn_mfma_f32_32x32x16_bf16(pa0, PK(l0, h0), od, 0, 0, 0);
  od = __builtin_amdgcn_mfma_f32_32x32x16_bf16(pa1, PK(l1, h1), od, 0, 0, 0);
  od = __builtin_amdgcn_mfma_f32_32x32x16_bf16(pa2, PK(l2, h2), od, 0, 0, 0);
  od = __builtin_amdgcn_mfma_f32_32x32x16_bf16(pa3, PK(l3, h3), od, 0, 0, 0);
#undef PK
}
DEVI void pv_d0(f32x16* o, int vb, bf16x8 pa0, bf16x8 pa1, bf16x8 pa2, bf16x8 pa3) { pv_one<0>(o[0], vb, pa0, pa1, pa2, pa3); pv_one<1>(o[1], vb, pa0, pa1, pa2, pa3); }
template <int D0> DEVI i32x8 v_frag8(int vb) { using a128::tr_read;
  const s16x4 l0 = tr_read<v_rd_off(D0, 0, 0)>(vb), h0 = tr_read<v_rd_off(D0, 0, 1)>(vb), l1 = tr_read<v_rd_off(D0, 1, 0)>(vb), h1 = tr_read<v_rd_off(D0, 1, 1)>(vb);
  typedef int i32x2_ __attribute__((ext_vector_type(2)));
  const i32x2_ a = __builtin_bit_cast(i32x2_, l0), b = __builtin_bit_cast(i32x2_, h0), c = __builtin_bit_cast(i32x2_, l1), d = __builtin_bit_cast(i32x2_, h1);
  return (i32x8){a[0], a[1], b[0], b[1], c[0], c[1], d[0], d[1]}; }
DEVI void pv_d08(f32x16* o, f32x16& ls, int vb, const i32x8 pa) {
  const i32x8 f0 = v_frag8<0>(vb), f1 = v_frag8<1>(vb);
  const int one4 = 0x38383838; ls = __builtin_amdgcn_mfma_scale_f32_32x32x64_f8f6f4(pa, (i32x8){one4, one4, one4, one4, one4, one4, one4, one4}, ls, 0, 0, 0, 0x7F7F7F7F, 0, 0x7F7F7F7F);
  asm volatile("s_waitcnt lgkmcnt(0)" ::: "memory"); SBAR();
  o[0] = __builtin_amdgcn_mfma_scale_f32_32x32x64_f8f6f4(pa, f0, o[0], 0, 0, 0, 0x7F7F7F7F, 0, 0x7F7F7F7F);
  o[1] = __builtin_amdgcn_mfma_scale_f32_32x32x64_f8f6f4(pa, f1, o[1], 0, 0, 0, 0x7F7F7F7F, 0, 0x7F7F7F7F);
}
DEVI void body(const bf16_t* __restrict__ Qb, const unsigned char* __restrict__ Kh, const unsigned char* __restrict__ Vh, bf16_t* __restrict__ Ob, int qpos0, int wstart, int nwin, float sink, LAS char* ldsl) {
  using a128::finishSM8;
  const int tid = TIDX, wid = tid >> 6, lane = tid & 63, r32 = lane & 31, hi = lane >> 5;
  char* lds = (char*)ldsl;
  char* V_lds = lds; char* K_lds = lds + 2 * SHM_V;
  float* ws = (float*)(lds + 2 * SHM_V + 2 * SHM_K) + wid * 64; float* li_l = ws; float* al_l = ws + 32;
  float m_reg = sink * (1.f / SCALE), l_reg = 1.f; f32x16 o[2] = {}; f32x16 ls; i32x8 qr;
#pragma unroll
  for (int r = 0; r < 16; ++r) ls[r] = 2.f;
  { const bf16_t* Qw = Qb + (long)(wid * QBLK + r32) * LDQ + hi * 32; bf16x8 qv[4];
#pragma unroll
    for (int c = 0; c < 4; ++c) qv[c] = *(const bf16x8*)(Qw + c * 8);
    const u32x2 c0 = a128::k8pack(qv[0]), c1 = a128::k8pack(qv[1]), c2 = a128::k8pack(qv[2]), c3 = a128::k8pack(qv[3]);
    qr = (i32x8){(int)c0[0], (int)c0[1], (int)c1[0], (int)c1[1], (int)c2[0], (int)c2[1], (int)c3[0], (int)c3[1]}; }
  const int sr = tid >> 3, sc = (tid & 7) * 8, va = tid >> 4, vc = (tid & 15) * 4, vst0 = v_st(va, vc);
  const int vb0 = (int)(uintptr_t)ldsl + a128::v_rd_base(lane);
  const int qpos = qpos0 + wid * QBLK + r32;
  struct { unsigned ve, vo; u32x2 ks0; } sr_[2];
#define KSTART(j) ((j) < nwin ? wstart + (j) * KVBLK : T + ((j) - nwin) * KVBLK)
  const unsigned loff0 = (unsigned)(sr * LDK + sc), lvf0 = (unsigned)(2 * va * LDK + vc);
#define SLOAD(i, j) do { const size_t _k = (size_t)KSTART(j) * LDK; sr_[i].ve = *(const unsigned*)((const char*)Vh + _k + lvf0); sr_[i].vo = *(const unsigned*)((const char*)Vh + _k + lvf0 + LDK); sr_[i].ks0 = *(const u32x2*)((const char*)Kh + _k + loff0); } while (0)
#define SWRITE(b, i) do { *(u32x2*)(V_lds + (b) * SHM_V + vst0) = (u32x2){__builtin_amdgcn_perm(sr_[i].vo, sr_[i].ve, 0x05010400u), __builtin_amdgcn_perm(sr_[i].vo, sr_[i].ve, 0x07030602u)}; \
    *(u32x2*)(K_lds + (b) * SHM_K + KSWZ4(sr, sc)) = sr_[i].ks0; } while (0)
#define SWAIT() asm volatile("s_waitcnt vmcnt(3)" ::: "memory")
#define RESC(a) do { if (__any((a) < 1.f)) { if (hi == 0) al_l[r32] = (a); asm volatile("s_waitcnt lgkmcnt(0)" ::: "memory"); \
    for (int r = 0; r < 16; ++r) { const float _al = al_l[crow(r, hi)]; ls[r] *= _al; o[0][r] *= _al; o[1][r] *= _al; } } } while (0)
#define PSM(P0, P1, MN, AL, j) partialSM(P0, P1, m_reg, MN, AL, (j) < nwin, KSTART(j) + 4 * hi - qpos)
  f32x16 pA0, pA1, pB0, pB1; float mnA, mnB, alA, alB; i32x8 pa8; const int NT = nwin + 4;
  constexpr int SE = 0, SO = 1;
  SLOAD(SE, 0); asm volatile("s_waitcnt vmcnt(0)" ::: "memory"); SWRITE(0, SE); __syncthreads();
  qkt(pA0, pA1, K_lds, qr, r32, hi); PSM(pA0, pA1, mnA, alA, 0);
  SLOAD(SO, 1); if (2 < NT) SLOAD(SE, 2);
  SWAIT(); SWRITE(1, SO); __syncthreads();
  for (int j = 1; j + 1 < NT; j += 2) {
    SBAR(); qkt(pB0, pB1, K_lds + SHM_K, qr, r32, hi);
    finishSM8(pA0, pA1, alA, l_reg, pa8); SBAR();
    SLOAD(SO, j + 2); SBAR();
    pv_d08(o, ls, vb0, pa8); PSM(pB0, pB1, mnB, alB, j);
    __syncthreads(); SWAIT(); SWRITE(0, SE);
    RESC(alB); __syncthreads();
    SBAR(); qkt(pA0, pA1, K_lds, qr, r32, hi);
    finishSM8(pB0, pB1, alB, l_reg, pa8); SBAR();
    if (j + 3 < NT) SLOAD(SE, j + 3); SBAR();
    pv_d08(o, ls, vb0 + (int)SHM_V, pa8); PSM(pA0, pA1, mnA, alA, j + 1);
    __syncthreads(); SWAIT(); SWRITE(1, SO);
    RESC(alA); __syncthreads();
  }
  SBAR(); qkt(pB0, pB1, K_lds + SHM_K, qr, r32, hi);
  finishSM8(pA0, pA1, alA, l_reg, pa8); SBAR();
  pv_d08(o, ls, vb0, pa8); PSM(pB0, pB1, mnB, alB, NT - 1);
  __syncthreads(); RESC(alB);
  finishSM8(pB0, pB1, alB, l_reg, pa8); SBAR();
  pv_d08(o, ls, vb0 + (int)SHM_V, pa8);
  float rli[16];
#pragma unroll
  for (int r = 0; r < 16; ++r) rli[r] = __builtin_amdgcn_rcpf(ls[r]);
  bf16_t* Ow = Ob + (long)(wid * QBLK) * LDO;
#pragma unroll
  for (int r = 0; r < 16; ++r) { int orow = crow(r, hi);
    for (int d0 = 0; d0 < 2; ++d0) Ow[(long)orow * LDO + d0 * 32 + r32] = f2bf(o[d0][r] * rli[r]); }
#undef KSTART
#undef SLOAD
#undef SWRITE
#undef SWAIT
#undef RESC
#undef PSM
}
}
DEVI void deal_kv(int u, int nkv, int& b, int& h, int& qb) {
    if (gridDim.x == 256) { const int r = u >> 8, c = u & 255, x = c & 7, li = c >> 3, ui = (x & 1) * 32 + li, G = r * 4 + (x >> 1); b = G / nkv; h = (G % nkv) * 4 + (ui >> 4); qb = ui & 15; }
    else { qb = u % 16; h = (u / 16) % (4 * nkv); b = u / (64 * nkv); }
}
DEVI void ph_attn_b(const P& p, int l) {
    const bf16_t* Qb = WSP(bf16_t, WS_QB); const bf16_t* Kb = WSP(bf16_t, WS_KB); const bf16_t* Vb = WSP(bf16_t, WS_VT); bf16_t* Ob = WSP(bf16_t, WS_O);
    const int nlat = NB * 16 * (T / 256), nctx = (l == DEPTH - 1) ? 0 : NB * 16;
    for (int u = BIDX; u < nlat + nctx; u += gridDim.x) {
        __syncthreads();
        if (u < nlat) { int qb, h, b; deal_kv(u, 4, b, h, qb); const int q0p = qb * 256; const size_t q0 = ((size_t)b * T + q0p) * D + h * 64, k0 = (size_t)b * KVLEN * 256 + (h >> 2) * 64;
            const int ws = q0p - 128 < 0 ? 0 : q0p - 128, we = q0p + 384 > T ? T : q0p + 384;
            a64::body(Qb + q0, (const unsigned char*)Kb + k0, (const unsigned char*)Vb + k0, Ob + q0, q0p, ws, (we - ws) / 64, p.b_sink[(l / 3) * 16 + h], (LAS char*)(shm + 1024)); }
        else { const int v = u - nlat, h = v % 16, b = v / 16; const size_t q0 = ((size_t)RL + b * CL) * D + h * 64, k0 = (size_t)b * KVLEN * 256 + (h >> 2) * 64;
            a64::body(Qb + q0, (const unsigned char*)Kb + k0, (const unsigned char*)Vb + k0, Ob + q0, -1000000, 0, 0, p.b_sink[(l / 3) * 16 + h], (LAS char*)(shm + 1024)); }
    }
}

DEVI void ph_attn_a(const P& p, int l) {
    const bf16_t* Qb = WSP(bf16_t, WS_QB); const bf16_t* Kb = WSP(bf16_t, WS_KB); const bf16_t* Vb = WSP(bf16_t, WS_VT); bf16_t* Ob = WSP(bf16_t, WS_O);
    const int nlat = NB * 8 * (T / 256), nctx = (l == DEPTH - 1) ? 0 : NB * 8;
    for (int u = BIDX; u < nlat + nctx; u += gridDim.x) {
        __syncthreads();
        const bool isl = u < nlat; const int v = isl ? u : u - nlat; int h = v % 8, b = v / 8, qb = 0; if (isl) deal_kv(u, 2, b, h, qb);
        const size_t q0 = (isl ? (size_t)b * T + qb * 256 : (size_t)RL + b * CL) * D + h * 128, k0 = ((size_t)b * KVLEN + (isl ? 0 : T)) * 256 + (h >> 2) * 128;
        a128::body(Qb + q0, (const unsigned char*)Kb + k0, (const unsigned char*)Vb + k0, Ob + q0, isl ? KVLEN : CL, (LAS char*)(shm + 1024));
    }
}

DEVI void ph_wo_probe(const P& p, int l) {
    g8::PlainOrder S{}; S.A = (const char*)WSP(bf16_t, WS_O); S.B = (const char*)(WSP(bf16_t, WS_WO) + (size_t)l * 1024 * 1024); S.ng = 1; S.nM = R / 256; S.nN = 4; S.K = 1024;
    g8::EpiF32 e{WSP(float, WS_QKV), 1024}; g8::gemm_phase(G8LDS, 1024, S, e); __syncthreads(); }
DEVI void ph_wo(const P& p, int l) {
    g8::PlainOrder S{}; S.A = (const char*)WSP(bf16_t, WS_O); S.B = (const char*)(WSP(bf16_t, WS_WO) + (size_t)l * 1024 * 1024); S.ng = 1; S.nM = (l == DEPTH - 1 ? RL : R) / 256; S.nN = 4; S.K = 1024;
    g8::EpiResid e{WSP(bf16_t, WS_X), WSP(float, WS_MODV) + (size_t)l * 9 * 6144 + 2 * 1024}; g8::gemm_phase(G8LDS, 1024, S, e); }

DEVI int block_excl_scan(int x, int& total, int* lds) {
    const int lane = TIDX & 63, wid = TIDX >> 6; int inc = x;
#pragma unroll
    for (int d = 1; d < 64; d <<= 1) { const int y = __shfl_up(inc, d); if (lane >= d) inc += y; }
    __syncthreads();
    if (lane == 63) lds[wid] = inc;
    __syncthreads();
    int base = 0, tot = 0;
#pragma unroll
    for (int w = 0; w < NWAVES; ++w) { const int v = lds[w]; if (w < wid) base += v; tot += v; }
    total = tot; return base + inc - x;
}
template <int VPT>
DEVI void select_topk(const P& p, int e, int n, int cap, int rowbase, int listbase, unsigned* lds) {
    const int tid = TIDX; const float* aff = WSP(float, WS_AFF);
    unsigned* hist = lds; unsigned* sel = lds + 256; int* scn = (int*)(lds + 272);
    unsigned v[VPT]; bool valid[VPT];
#pragma unroll
    for (int i = 0; i < VPT; ++i) { const int idx = tid * VPT + i; valid[i] = idx < n; v[i] = valid[i] ? __float_as_uint(aff[(size_t)(rowbase + idx) * 16 + e]) : 0u; }
    unsigned prefix = 0u, mask = 0u; int need = cap;
    for (int pass = 0; pass < 4; ++pass) {
        const int shift = 24 - 8 * pass;
        if (tid < 256) hist[tid] = 0u;
        __syncthreads();
#pragma unroll
        for (int i = 0; i < VPT; ++i) if (valid[i] && (v[i] & mask) == prefix) atomicAdd(&hist[(v[i] >> shift) & 255u], 1u);
        __syncthreads();
        {
          unsigned hv = 0u, sfx = 0u; const int ln = tid & 63, wv = tid >> 6;
          if (tid < 256) { hv = hist[tid]; sfx = hv;
#pragma unroll
              for (int dd = 1; dd < 64; dd <<= 1) { const unsigned y = __shfl_down(sfx, dd); if (ln + dd < 64) sfx += y; }
              if (ln == 0) sel[4 + wv] = sfx; }
          __syncthreads();
          if (tid < 256) { for (int w = wv + 1; w < 4; ++w) sfx += sel[4 + w]; const unsigned above = sfx - hv;
              if ((int)above < need && need <= (int)sfx) { sel[0] = (unsigned)tid; sel[1] = (unsigned)(need - (int)above); } } }
        __syncthreads();
        prefix |= sel[0] << shift; mask |= 255u << shift; need = (int)sel[1];
        __syncthreads();
    }
    int ceq = 0;
#pragma unroll
    for (int i = 0; i < VPT; ++i) ceq += (valid[i] && v[i] == prefix) ? 1 : 0;
    int tot; int eqr = block_excl_scan(ceq, tot, scn);
    bool take[VPT]; int ct = 0;
#pragma unroll
    for (int i = 0; i < VPT; ++i) { take[i] = valid[i] && (v[i] > prefix || (v[i] == prefix && eqr < need)); if (valid[i] && v[i] == prefix) ++eqr; ct += take[i] ? 1 : 0; }
    int pos = block_excl_scan(ct, tot, scn);
    int* IDX = WSP(int, WS_IDX); float* GATE = WSP(float, WS_GATE); int* SLOT = WSP(int, WS_SLOT);
#pragma unroll
    for (int i = 0; i < VPT; ++i) if (valid[i]) { const int row = rowbase + tid * VPT + i;
        if (take[i]) { IDX[e * EROWS + listbase + pos] = row; GATE[e * EROWS + listbase + pos] = __uint_as_float(v[i]); SLOT[(size_t)e * R + row] = listbase + pos; ++pos; }
        else SLOT[(size_t)e * R + row] = -1; }
    __syncthreads();
}
DEVI void ph_select(const P& p, int l, unsigned* lds) {
    const int nit = (l == DEPTH - 1) ? NB * NE : 2 * NB * NE;
    for (int item = BIDX; item < nit; item += gridDim.x) { const int q = item % (NB * NE), b = q / NE, e = q % NE;
        if (item < NB * NE) select_topk<8>(p, e, T, CAPL, b * T, b * CAPL, lds);
        else select_topk<1>(p, e, CL, CAPC, RL + b * CL, NB * CAPL + b * CAPC, lds); }
}
DEVI void ph_ffn1(const P& p, int l) {
    g8::ExpertOrder S{(const char*)WSP(bf16_t, WS_H), (const char*)WSP(bf16_t, WS_F1), WSP(int, WS_IDX), (size_t)4096 * 1024, l == DEPTH - 1 ? NB * CAPL / 256 : EROWS / 256, 16, 512, EROWS / 256};
    g8::EpiSwiGLU e{WSP(unsigned char, WS_HID)}; g8::gemm_phase<g8::EpiSwiGLU, g8::ExpertOrder, true, true>(G8LDS, 512, S, e, F1_SCALE); }
DEVI void ph_ffn2(const P& p, int l) {
    g8::ExpertOrder S{(const char*)WSP(bf16_t, WS_HID), (const char*)WSP(bf16_t, WS_F2), nullptr, (size_t)1024 * 2048, l == DEPTH - 1 ? NB * CAPL / 256 : EROWS / 256, 4, 1024, EROWS / 256};
    g8::EpiGate e{WSP(bf16_t, WS_YEXP), WSP(float, WS_GATE)}; g8::gemm_phase<g8::EpiGate, g8::ExpertOrder, false, true>(G8LDS, 1024, S, e, F2_SCALE); }

DEVI void ph_rwkv_mix(const P& p) {
    const int lane = TIDX & 63, gw = BIDX * NWAVES + (TIDX >> 6), nw = gridDim.x * NWAVES;
    const bf16_t* Hb = WSP(bf16_t, WS_H); bf16_t* xm = WSP(bf16_t, WS_U1);
    f32x4 mu[6][4];
#pragma unroll
    for (int j = 0; j < 6; ++j)
#pragma unroll
        for (int i = 0; i < 4; ++i) mu[j][i] = *(const f32x4*)(p.c_mu + j * 1024 + 4 * lane + 256 * i);
    for (int row = gw; row < R; row += nw) {
        int tt, len; if (row < RL) { tt = row & 4095; len = T; } else { tt = (row - RL) & 255; len = CL; }
        const size_t o0 = (size_t)row * D + 4 * lane; f32x4 h[4], hp[4], hn[4]; u32x2 hw[4], pw[4], nw2[4];
        const float mp = tt > 0 ? 1.f : 0.f, mn2 = tt < len - 1 ? 1.f : 0.f; const size_t op = tt > 0 ? o0 - D : o0, on2 = tt < len - 1 ? o0 + D : o0;
#pragma unroll
        for (int i = 0; i < 4; ++i) { hw[i] = *(const u32x2*)(Hb + o0 + 256 * i); pw[i] = *(const u32x2*)(Hb + op + 256 * i); nw2[i] = *(const u32x2*)(Hb + on2 + 256 * i); }
#pragma unroll
        for (int i = 0; i < 4; ++i) { h[i] = (f32x4){bflo(hw[i][0]), bfhi(hw[i][0]), bflo(hw[i][1]), bfhi(hw[i][1])}; hp[i] = (f32x4){bflo(pw[i][0]), bfhi(pw[i][0]), bflo(pw[i][1]), bfhi(pw[i][1])} * mp; hn[i] = (f32x4){bflo(nw2[i][0]), bfhi(nw2[i][0]), bflo(nw2[i][1]), bfhi(nw2[i][1])} * mn2; }
#pragma unroll
        for (int i = 0; i < 4; ++i) { const f32x4 xx = (hp[i] + hn[i]) * 0.5f - h[i];
#pragma unroll
            for (int j = 0; j < 6; ++j) { const f32x4 v = h[i] + xx * mu[j][i];
                const int slot = j == 0 ? 0 : (j == 1 ? 3 : (j == 2 ? 1 : (j == 3 ? 2 : j)));
                u32x2 w = {cvt_pk_bf16(v[0], v[1]), cvt_pk_bf16(v[2], v[3])}; *(u32x2*)(xm + (size_t)slot * R * D + o0 + 256 * i) = w; } }
    }
}
DEVI void ph_rwkv_gemm1(const P& p) {
    const size_t S = (size_t)R * D; bf16_t* l1 = WSP(bf16_t, WS_L1);
    g8::G1Order O{(const char*)WSP(bf16_t, WS_U1), (const char*)WSP(bf16_t, WS_WRKV), (const char*)WSP(bf16_t, WS_WL1), S * 2, R / 256};
    g8::EpiG1 e{WSP(bf16_t, WS_RKVB), S, l1, l1 + (size_t)R * 256}; g8::gemm_phase(G8LDS, 1024, O, e);
}
DEVI void ph_rwkv_gemm2(const P& p) {
    const size_t S = (size_t)R * D; const bf16_t* l1 = WSP(bf16_t, WS_L1); const bf16_t* wl2 = WSP(bf16_t, WS_WL2);
    { g8::PlainOrder O{}; O.A = (const char*)l1; O.B = (const char*)wl2; O.ng = 1; O.nM = R / 256; O.nN = 16; O.K = 256;
      g8::EpiWA e{WSP(bf16_t, WS_U1), S, (bf16_t*)(WSP(float, WS_U1) + 2 * S), p.c_w0, p.c_a0}; g8::gemm_phase(G8LDS, 256, O, e); }
    __syncthreads();
    { g8::PlainOrder O{}; O.A = (const char*)(l1 + (size_t)R * 256); O.B = (const char*)(wl2 + (size_t)4096 * 256); O.ng = 1; O.nM = R / 256; O.nN = 4; O.K = 128;
      g8::EpiBf16 e{WSP(bf16_t, WS_GB), 0, 1024}; g8::gemm_phase(G8LDS, 128, O, e); }
}
DEVI float dpp_sum16(float v) {
    v += __builtin_bit_cast(float, __builtin_amdgcn_update_dpp(0, __builtin_bit_cast(int, v), 0xB1, 0xF, 0xF, true));
    v += __builtin_bit_cast(float, __builtin_amdgcn_update_dpp(0, __builtin_bit_cast(int, v), 0x4E, 0xF, 0xF, true));
    v += __builtin_bit_cast(float, __builtin_amdgcn_update_dpp(0, __builtin_bit_cast(int, v), 0x141, 0xF, 0xF, true));
    v += __builtin_bit_cast(float, __builtin_amdgcn_update_dpp(0, __builtin_bit_cast(int, v), 0x140, 0xF, 0xF, true));
    return v;
}
DEVI void ph_rwkv_scan(const P& p, float* lds) {
    const int tid = TIDX, lane = tid & 63, wid = tid >> 6, jg = lane & 15, ip = wid * 4 + (lane >> 4);
    const size_t SZ = (size_t)R * D; const bf16_t* rkv = WSP(bf16_t, WS_RKVB); const float* wd = WSP(float, WS_U1); const float* ad = wd + 2 * SZ; float* ofb = WSP(float, WS_OFB);
    constexpr int NCH = (CL + T) / 32;
    float* obuf = lds + 2 * 32 * 384;
    for (int chain = BIDX; chain < 2 * NB * 16; chain += gridDim.x) {
        const int d = chain / (NB * 16), b = (chain / 16) % NB, h = chain % 16, col = h * 64 + lane;
        const float kk_c = p.c_k_k[col], ka_c = p.c_k_a[col];
        auto row_of = [&](int g) { return g < CL ? RL + b * CL + (d == 0 ? g : CL - 1 - g) : b * T + (d == 0 ? g - CL : T - 1 - (g - CL)); };
        bf16_t pr[4], pk[4], pv[4]; float pw[4], pa[4];
        auto issue = [&](int ci) {
#pragma unroll
            for (int q = 0; q < 4; ++q) { const size_t o = (size_t)row_of(ci * 32 + wid + 8 * q) * D + col; pr[q] = rkv[o]; pk[q] = rkv[SZ + o]; pv[q] = rkv[2 * SZ + o]; pw[q] = wd[d * SZ + o]; pa[q] = ad[d * SZ + o]; } };
        auto stage = [&](int buf) {
#pragma unroll
            for (int q = 0; q < 4; ++q) { const float r = bf2f(pr[q]), k = bf2f(pk[q]), v = bf2f(pv[q]), w = pw[q], a = pa[q];
                const float kkv = k * kk_c; const float ss = wave_sum(kkv * kkv); const float kkn = kkv * rsqrtf(fmaxf(ss, 1e-24f));
                float* vs = lds + buf * (32 * 384) + (wid + 8 * q) * 384; vs[lane] = r; vs[64 + lane] = w; vs[128 + lane] = k * (1.f + (a - 1.f) * ka_c); vs[192 + lane] = -kkn; vs[256 + lane] = kkn * a; vs[320 + lane] = v; } };
        f32x2 S00 = {0.f, 0.f}, S01 = {0.f, 0.f}, S10 = {0.f, 0.f}, S11 = {0.f, 0.f};
        __syncthreads();
        issue(0); stage(0);
        __syncthreads();
        for (int ci = 0; ci < NCH; ++ci) {
            if (ci + 1 < NCH) issue(ci + 1);
            const float* vb = lds + (ci & 1) * (32 * 384) + 4 * jg; const float* vv = lds + (ci & 1) * (32 * 384) + 320 + 2 * ip;
            f32x4 r4 = *(const f32x4*)vb, w4 = *(const f32x4*)(vb + 64), k4 = *(const f32x4*)(vb + 128), a4 = *(const f32x4*)(vb + 192), b4 = *(const f32x4*)(vb + 256); f32x2 v2 = *(const f32x2*)vv;
#pragma unroll 4
            for (int s = 0; s < 32; ++s) {
                const int sn = s < 31 ? s + 1 : 31;
                const f32x4 r4n = *(const f32x4*)(vb + sn * 384), w4n = *(const f32x4*)(vb + sn * 384 + 64), k4n = *(const f32x4*)(vb + sn * 384 + 128), a4n = *(const f32x4*)(vb + sn * 384 + 192), b4n = *(const f32x4*)(vb + sn * 384 + 256);
                const f32x2 v2n = *(const f32x2*)(vv + sn * 384);
                const f32x2 a01 = {a4[0], a4[1]}, a23 = {a4[2], a4[3]}, w01 = {w4[0], w4[1]}, w23 = {w4[2], w4[3]}, b01 = {b4[0], b4[1]}, b23 = {b4[2], b4[3]}, k01 = {k4[0], k4[1]}, k23 = {k4[2], k4[3]}, r01 = {r4[0], r4[1]}, r23 = {r4[2], r4[3]};
                f32x2 t0 = S00 * a01 + S01 * a23, t1 = S10 * a01 + S11 * a23;
                const float sa0 = dpp_sum16(t0[0] + t0[1]), sa1 = dpp_sum16(t1[0] + t1[1]);
                const f32x2 sa0v = {sa0, sa0}, sa1v = {sa1, sa1}, v0v = {v2[0], v2[0]}, v1v = {v2[1], v2[1]};
                S00 = S00 * w01 + sa0v * b01 + v0v * k01; S01 = S01 * w23 + sa0v * b23 + v0v * k23;
                S10 = S10 * w01 + sa1v * b01 + v1v * k01; S11 = S11 * w23 + sa1v * b23 + v1v * k23;
                t0 = S00 * r01 + S01 * r23; t1 = S10 * r01 + S11 * r23;
                const float o0 = dpp_sum16(t0[0] + t0[1]), o1 = dpp_sum16(t1[0] + t1[1]);
                if (jg == 0) *(f32x2*)(obuf + s * 64 + 2 * ip) = (f32x2){o0, o1};
                r4 = r4n; w4 = w4n; k4 = k4n; a4 = a4n; b4 = b4n; v2 = v2n;
            }
            __syncthreads();
            { const int s = tid >> 4, i4 = (tid & 15) * 4; *(f32x4*)(ofb + d * SZ + (size_t)row_of(ci * 32 + s) * D + h * 64 + i4) = *(const f32x4*)(obuf + s * 64 + i4); }
            if (ci + 1 < NCH) stage((ci + 1) & 1);
            __syncthreads();
        }
    }
}
namespace sc2 {
constexpr int SLOT = 11520;
DEVI int perm16(int t) { return 8 * ((t >> 2) & 1) + 4 * ((t >> 3) & 1) + (t & 3); }
DEVI float hsel(float x, int hi) { auto rr = __builtin_amdgcn_permlane32_swap(__float_as_uint(x), __float_as_uint(x), false, false); return __uint_as_float(hi ? rr[1] : rr[0]); }
DEVI void st16(LAS char* p, float v) { *(LAS unsigned short*)p = f2bf(v); }
template <int S> DEVI float bcast(float x) { return __builtin_bit_cast(float, __builtin_amdgcn_update_dpp(0, __builtin_bit_cast(int, x), 0x150 + S, 0xF, 0xF, true)); }
struct Raw { bf16_t ra[16], ka[16], va[16], sa[16], wa[16]; };
template <class RowOf>
DEVI void load_raw(const P& p, int d, int h, int c, Raw& w, RowOf row_of) {
    const int lane = TIDX & 63, col = h * 64 + lane; const size_t SZ = (size_t)R * D;
    const bf16_t* rkv = WSP(bf16_t, WS_RKVB); const bf16_t* wd = WSP(bf16_t, WS_U1) + (size_t)d * SZ; const bf16_t* ad = (const bf16_t*)(WSP(float, WS_U1) + 2 * SZ) + (size_t)d * SZ;
    bf16_t (&ra)[16] = w.ra, (&ka)[16] = w.ka, (&va)[16] = w.va, (&sa)[16] = w.sa, (&wa)[16] = w.wa;
    const int row0 = row_of(16 * c), rstep = row_of(16 * c + 1) - row0;
#pragma unroll
    for (int t = 0; t < 16; ++t) { const size_t ro = (size_t)__builtin_amdgcn_readfirstlane(row0 + rstep * t) * D;
        const bf16_t* r0 = rkv + ro; const bf16_t* r1 = rkv + SZ + ro; const bf16_t* r2 = rkv + 2 * SZ + ro; const bf16_t* r3 = wd + ro; const bf16_t* r4 = ad + ro;
        ra[t] = r0[col]; ka[t] = r1[col]; va[t] = r2[col]; wa[t] = r3[col]; sa[t] = r4[col]; }
}
DEVI void produce(const Raw& w, float kk_c, float ka_c, LAS char* slot) {
    const int lane = TIDX & 63;
    float ra[16], ka[16], va[16], sa[16], wa[16];
#pragma unroll
    for (int t = 0; t < 16; ++t) { ra[t] = bf2f(w.ra[t]); ka[t] = bf2f(w.ka[t]); va[t] = bf2f(w.va[t]); sa[t] = bf2f(w.sa[t]); wa[t] = __builtin_amdgcn_exp2f(-bf2f(w.wa[t])); }
    float at[16], rt[16], bt[16], kt[16]; float g = 1.f;
#pragma unroll
    for (int t = 0; t < 16; ++t) { const float kkv = ka[t] * kk_c; const float ss = wave_sum_dpp(kkv * kkv); const float kkn = kkv * rsqrtf(fmaxf(ss, 1e-24f));
        const float kd = ka[t] * (1.f + (sa[t] - 1.f) * ka_c), bv = kkn * sa[t];
        at[t] = -kkn * g; g *= wa[t]; rt[t] = ra[t] * g; const float ig = __builtin_amdgcn_rcpf(g); bt[t] = bv * ig; kt[t] = kd * ig; }
    { const int cb = (lane >> 3), wb = (lane & 7) * 2;
#pragma unroll
      for (int t = 0; t < 16; ++t) { const int o0 = t * 128 + ((cb ^ (t & 7)) << 4) + wb, o1 = (16 + t) * 128 + ((cb ^ (t & 7)) << 4) + wb;
          st16(slot + o0, at[t]); st16(slot + o1, rt[t]); st16(slot + 4096 + o0, bt[t]); st16(slot + 4096 + o1, kt[t]); } }
    asm volatile("s_waitcnt lgkmcnt(0)" ::: "memory");
    f32x16 dm = {};
    { const int m = lane & 31, hi = lane >> 5;
#pragma unroll
      for (int q = 0; q < 4; ++q) { const int o = m * 128 + (((2 * q + hi) ^ (m & 7)) << 4); const bf16x8 A = *(const LAS bf16x8*)(slot + o), B = *(const LAS bf16x8*)(slot + 4096 + o);
          dm = __builtin_amdgcn_mfma_f32_32x32x16_bf16(A, B, dm, 0, 0, 0); } }
    { float bp[16], kp[16];
#pragma unroll
      for (int t = 0; t < 16; ++t) { bp[8 * ((t >> 2) & 1) + 4 * ((t >> 3) & 1) + (t & 3)] = bt[t] * g; kp[t] = kt[t] * g; }
      u32x4 w0 = {cvt_pk_bf16(bp[0], bp[1]), cvt_pk_bf16(bp[2], bp[3]), cvt_pk_bf16(bp[4], bp[5]), cvt_pk_bf16(bp[6], bp[7])}, w1 = {cvt_pk_bf16(bp[8], bp[9]), cvt_pk_bf16(bp[10], bp[11]), cvt_pk_bf16(bp[12], bp[13]), cvt_pk_bf16(bp[14], bp[15])};
      *(LAS u32x4*)(slot + 4096 + lane * 32) = w0; *(LAS u32x4*)(slot + 4096 + lane * 32 + 16) = w1;
      u32x4 k0 = {cvt_pk_bf16(kp[0], kp[1]), cvt_pk_bf16(kp[2], kp[3]), cvt_pk_bf16(kp[4], kp[5]), cvt_pk_bf16(kp[6], kp[7])}, k1 = {cvt_pk_bf16(kp[8], kp[9]), cvt_pk_bf16(kp[10], kp[11]), cvt_pk_bf16(kp[12], kp[13]), cvt_pk_bf16(kp[14], kp[15])};
      *(LAS u32x4*)(slot + 6144 + lane * 32) = k0; *(LAS u32x4*)(slot + 6144 + lane * 32 + 16) = k1;
      u32x4 v0 = {cvt_pk_bf16(va[0], va[1]), cvt_pk_bf16(va[2], va[3]), cvt_pk_bf16(va[4], va[5]), cvt_pk_bf16(va[6], va[7])}, v1 = {cvt_pk_bf16(va[8], va[9]), cvt_pk_bf16(va[10], va[11]), cvt_pk_bf16(va[12], va[13]), cvt_pk_bf16(va[14], va[15])};
      *(LAS u32x4*)(slot + 9216 + lane * 32) = v0; *(LAS u32x4*)(slot + 9216 + lane * 32 + 16) = v1;
      *(LAS float*)(slot + 11264 + lane * 4) = g; }
    __builtin_amdgcn_sched_barrier(0);
#define ROWS(m, x0, x1) do { const float _h = hsel(dm[((m) & 3) + 4 * ((m) >> 3)], ((m) >> 2) & 1); auto _rr = __builtin_amdgcn_permlane16_swap(__float_as_uint(_h), __float_as_uint(_h), false, false); x0 = __uint_as_float(_rr[0]); x1 = __uint_as_float(_rr[1]); } while (0)
    const int l16 = lane & 15;
#define SUB1(S) if (S < t) { const float nv = bcast<S>(nabt); acc = acc + (f32x2){nv, nv} * ap[S]; }
#define SUB2(S) if (S <= t) { const float mv = bcast<S>(mbrt); acc = acc + (f32x2){mv, mv} * ap[S]; }
#define ALL16(M) M(0) M(1) M(2) M(3) M(4) M(5) M(6) M(7) M(8) M(9) M(10) M(11) M(12) M(13) M(14) M(15)
    f32x2 ap[16], qg[16];
#pragma unroll
    for (int t = 0; t < 16; ++t) { float nabt, nakt; ROWS(t, nabt, nakt); f32x2 acc = {at[t], (l16 < t) ? nakt : 0.f}; ALL16(SUB1) ap[t] = acc; __builtin_amdgcn_sched_barrier(0); }
#pragma unroll
    for (int t = 0; t < 16; ++t) { float mbrt, mkrt; ROWS(16 + t, mbrt, mkrt); f32x2 acc = {rt[t], (l16 <= t) ? mkrt : 0.f}; ALL16(SUB2) qg[t] = acc; __builtin_amdgcn_sched_barrier(0); }
#undef SUB1
#undef SUB2
#undef ALL16
#undef ROWS
    { const int pj = (lane & ~12) | ((lane & 4) << 1) | ((lane & 8) >> 1), cb = pj >> 3, wb = (pj & 7) * 2;
#pragma unroll
      for (int t = 0; t < 16; ++t) { st16(slot + t * 128 + ((cb ^ (t & 7)) << 4) + wb, ap[t][0]); st16(slot + (16 + t) * 128 + ((cb ^ (t & 7)) << 4) + wb, qg[t][0]); } }
    if (lane < 16) {
#pragma unroll
        for (int t = 0; t < 16; ++t) { st16(slot + 8192 + t * 32 + l16 * 2, ap[t][1]); st16(slot + 8192 + (16 + t) * 32 + l16 * 2, qg[t][1]); } }
}
template <class RowOf>
DEVI void consume(f32x16& ST0, f32x16& ST1, const LAS char* slot, int it, int c, bf16_t* out  , RowOf row_of) {
    const int lane = TIDX & 63, n = lane & 31, hi = lane >> 5;
    f32x16 x = {};
#pragma unroll
    for (int q = 0; q < 4; ++q) { const f32x16& S = (q >> 1) ? ST1 : ST0; const int r0 = 8 * (q & 1);
        const u32x4 w = {cvt_pk_bf16(S[r0], S[r0 + 1]), cvt_pk_bf16(S[r0 + 2], S[r0 + 3]), cvt_pk_bf16(S[r0 + 4], S[r0 + 5]), cvt_pk_bf16(S[r0 + 6], S[r0 + 7])};
        const bf16x8 A = *(const LAS bf16x8*)(slot + n * 128 + (((2 * q + hi) ^ (n & 7)) << 4));
        x = __builtin_amdgcn_mfma_f32_32x32x16_bf16(A, __builtin_bit_cast(bf16x8, w), x, 0, 0, 0); }
    const bf16x8 vf = *(const LAS bf16x8*)(slot + 9216 + (32 * it + n) * 32 + hi * 16);
    { const bf16x8 A5 = *(const LAS bf16x8*)(slot + 8192 + n * 32 + hi * 16); x = __builtin_amdgcn_mfma_f32_32x32x16_bf16(A5, vf, x, 0, 0, 0); }
    const u32x4 uw = {cvt_pk_bf16(x[0], x[1]), cvt_pk_bf16(x[2], x[3]), cvt_pk_bf16(x[4], x[5]), cvt_pk_bf16(x[6], x[7])}; const bf16x8 ub = __builtin_bit_cast(bf16x8, uw);
#pragma unroll
    for (int r = 8; r < 16; ++r) { const int t = (r & 3) + 8 * ((r >> 2) - 2) + 4 * hi; out[(size_t)row_of(16 * c + t) * D + n] = f2bf(x[r]); }
#pragma unroll
    for (int jt = 0; jt < 2; ++jt) { f32x16& S = jt ? ST1 : ST0; f32x16 C;
#pragma unroll
        for (int gq = 0; gq < 4; ++gq) { const f32x4 gv = *(const LAS f32x4*)(slot + 11264 + (32 * jt + 8 * gq + 4 * hi) * 4);
#pragma unroll
            for (int e = 0; e < 4; ++e) C[4 * gq + e] = S[4 * gq + e] * gv[e]; }
        const bf16x8 Ab = *(const LAS bf16x8*)(slot + 4096 + (32 * jt + n) * 32 + hi * 16), Ak = *(const LAS bf16x8*)(slot + 6144 + (32 * jt + n) * 32 + hi * 16);
        C = __builtin_amdgcn_mfma_f32_32x32x16_bf16(Ab, ub, C, 0, 0, 0); C = __builtin_amdgcn_mfma_f32_32x32x16_bf16(Ak, vf, C, 0, 0, 0); S = C; }
}
}
DEVI void ph_rwkv_scan2(const P& p) {
    const int wid = __builtin_amdgcn_readfirstlane(TIDX >> 6), lane = TIDX & 63; const size_t SZ = (size_t)R * D;
    LAS char* slots = (LAS char*)(shm + 1024);
    for (int chain = BIDX; chain < 2 * NB * 16; chain += gridDim.x) {
        const int d = chain / (NB * 16), b = (chain / 16) % NB, h = chain % 16;
        const float kk_c = p.c_k_k[h * 64 + lane], ka_c = p.c_k_a[h * 64 + lane];
        auto row_of = [&](int g) { return g < CL ? RL + b * CL + (d == 0 ? g : CL - 1 - g) : b * T + (d == 0 ? g - CL : T - 1 - (g - CL)); };
        f32x16 ST0 = {}, ST1 = {};
        bf16_t* out = WSP(bf16_t, WS_OFB) + (size_t)d * SZ + h * 64 + 32 * (wid & 1);
        constexpr int NCHUNK = (CL + T) / 16, PB = 6, NBATCH = (NCHUNK + PB - 1) / PB;
        const int pw = wid - 2;
        sc2::Raw raw;
        if (wid >= 2) { sc2::load_raw(p, d, h, pw, raw, row_of); sc2::produce(raw, kk_c, ka_c, slots + pw * sc2::SLOT); sc2::load_raw(p, d, h, PB + pw, raw, row_of); }
        __syncthreads();
#pragma unroll 1
        for (int bi = 0; bi < NBATCH; ++bi) {
            if (wid >= 2) { const int c = PB * (bi + 1) + pw;
                if (c < NCHUNK) { sc2::produce(raw, kk_c, ka_c, slots + (((bi + 1) & 1) * PB + pw) * sc2::SLOT);
                    if (c + PB < NCHUNK) sc2::load_raw(p, d, h, c + PB, raw, row_of); } }
            else { const int n = NCHUNK - PB * bi < PB ? NCHUNK - PB * bi : PB;
#pragma unroll 1
                for (int s2 = 0; s2 < n; ++s2) sc2::consume(ST0, ST1, slots + ((bi & 1) * PB + s2) * sc2::SLOT, wid, PB * bi + s2, out, row_of); }
            __syncthreads();
        }
    }
}
DEVI void ph_rwkv_readout(const P& p) {
    const int lane = TIDX & 63, gw = BIDX * NWAVES + (TIDX >> 6), nw = gridDim.x * NWAVES;
    const size_t SZ = (size_t)R * D; const bf16_t* rkv = WSP(bf16_t, WS_RKVB); const bf16_t* ad = (const bf16_t*)(WSP(float, WS_U1) + 2 * SZ); const bf16_t* ofb = WSP(bf16_t, WS_OFB);
    const bf16_t* gb = WSP(bf16_t, WS_GB); bf16_t* O = WSP(bf16_t, WS_O);
    f32x4 ka[4], rk0[4], rk1[4], lw[4], lb[4];
#pragma unroll
    for (int i = 0; i < 4; ++i) { const int c0 = 4 * lane + 256 * i; ka[i] = *(const f32x4*)(p.c_k_a + c0); rk0[i] = *(const f32x4*)(p.c_r_k + c0); rk1[i] = *(const f32x4*)(p.c_r_k + 1024 + c0);
        lw[i] = *(const f32x4*)(p.c_ln_w + c0); lb[i] = *(const f32x4*)(p.c_ln_b + c0); }
    for (int row = gw; row < R; row += nw) {
        const size_t o0 = (size_t)row * D + 4 * lane;
        u32x2 ofw[4], obw[4], a0w[4], a1w[4], rw[4], kw[4], vw[4], gw2[4];
#pragma unroll
        for (int i = 0; i < 4; ++i) { const size_t o = o0 + 256 * i; ofw[i] = *(const u32x2*)(ofb + o); obw[i] = *(const u32x2*)(ofb + SZ + o); a0w[i] = *(const u32x2*)(ad + o); a1w[i] = *(const u32x2*)(ad + SZ + o);
            rw[i] = *(const u32x2*)(rkv + o); kw[i] = *(const u32x2*)(rkv + SZ + o); vw[i] = *(const u32x2*)(rkv + 2 * SZ + o); gw2[i] = *(const u32x2*)(gb + o); }
#pragma unroll
        for (int i = 0; i < 4; ++i) {
            const f32x4 a0i = {bflo(a0w[i][0]), bfhi(a0w[i][0]), bflo(a0w[i][1]), bfhi(a0w[i][1])}, a1i = {bflo(a1w[i][0]), bfhi(a1w[i][0]), bflo(a1w[i][1]), bfhi(a1w[i][1])};
            f32x4 ov = (f32x4){bflo(ofw[i][0]) + bflo(obw[i][0]), bfhi(ofw[i][0]) + bfhi(obw[i][0]), bflo(ofw[i][1]) + bflo(obw[i][1]), bfhi(ofw[i][1]) + bfhi(obw[i][1])};
            const float mean = dpp_sum16(ov[0] + ov[1] + ov[2] + ov[3]) * (1.f / 64.f); ov = ov - mean;
            const float var = dpp_sum16(ov[0] * ov[0] + ov[1] * ov[1] + ov[2] * ov[2] + ov[3] * ov[3]) * (1.f / 64.f); ov = ov * rsqrtf(var + 64e-5f);
            const f32x4 r = {bflo(rw[i][0]), bfhi(rw[i][0]), bflo(rw[i][1]), bfhi(rw[i][1])}, k = {bflo(kw[i][0]), bfhi(kw[i][0]), bflo(kw[i][1]), bfhi(kw[i][1])};
            const f32x4 v = {bflo(vw[i][0]), bfhi(vw[i][0]), bflo(vw[i][1]), bfhi(vw[i][1])}, g = {bflo(gw2[i][0]), bfhi(gw2[i][0]), bflo(gw2[i][1]), bfhi(gw2[i][1])};
            const f32x4 t0 = r * (k * ((a0i - 1.f) * ka[i] + 1.f)) * rk0[i], t1 = r * (k * ((a1i - 1.f) * ka[i] + 1.f)) * rk1[i];
            const float bs = dpp_sum16(t0[0] + t0[1] + t0[2] + t0[3] + t1[0] + t1[1] + t1[2] + t1[3]);
            const f32x4 res = (ov * lw[i] + lb[i] + v * bs) * g;
            u32x2 w = {cvt_pk_bf16(res[0], res[1]), cvt_pk_bf16(res[2], res[3])}; *(u32x2*)(O + o0 + 256 * i) = w; }
    }
}

typedef const P __attribute__((address_space(4)))* KP;
#define LDSF ((float*)(shm + 64))
DEVI P load_params(KP kp) { P p; __builtin_memcpy(&p, kp, sizeof(P)); return p; }
#ifndef PROBE_DUP
#define PROBE_DUP 0
#endif
#define PHASE_FN(name, call) DEVI void name(KP kp0, int l) { KP kp = kp0; asm volatile("" : "+s"(kp)); const P p = load_params(kp); (void)l; call; }
#define PHASE_FN_D(id, name, call) DEVI void name(KP kp0, int l) { KP kp = kp0; asm volatile("" : "+s"(kp)); const P p = load_params(kp); (void)l; call; if ((PROBE_DUP >> id) & 1) { __syncthreads(); call; } }
PHASE_FN(f_prologue, { ph_prologue(p, LDSF); if ((PROBE_DUP >> 17) & 1) { __syncthreads(); ph_prologue(p, LDSF); } })
PHASE_FN(f_norm1, { if ((PROBE_DUP >> 14) & 1) ph_norm1<false>(p, l); ph_norm1(p, l); cvt_ffn_norm1(p, l, LDSF); })
PHASE_FN(f_qkv_gemm, { ph_qkv_gemm(p, l); cvt_ffn_tail(p, l, LDSF, 1, (R / 256) * 6); })
PHASE_FN_D(2, f_qkv_post, ph_qkv_post(p, l))
PHASE_FN_D(3, f_attn_a, ph_attn_a(p, l))
PHASE_FN_D(4, f_attn_b, ph_attn_b(p, l))
PHASE_FN(f_wo, { if ((PROBE_DUP >> 15) & 1) ph_wo_probe(p, l); ph_wo(p, l); cvt_ffn_tail(p, l, LDSF, 2, (R / 256) * 4); })
PHASE_FN_D(5, f_mix, ph_rwkv_mix(p))
PHASE_FN_D(6, f_g1, ph_rwkv_gemm1(p))
PHASE_FN_D(7, f_g2, ph_rwkv_gemm2(p))
PHASE_FN_D(8, f_scan, ph_rwkv_scan2(p))
PHASE_FN_D(9, f_readout, ph_rwkv_readout(p))
PHASE_FN_D(10, f_norm2, ph_norm2(p, l, LDSF))
PHASE_FN_D(11, f_select, ph_select(p, l, (unsigned*)LDSF))
PHASE_FN(f_ffn1, { ph_ffn1(p, l); if ((PROBE_DUP >> 12) & 1) { __syncthreads(); ph_ffn1(p, l); } })
PHASE_FN(f_ffn2, { ph_ffn2(p, l); if (l + 1 < DEPTH) cvt_ffn_tail(p, l + 1, LDSF, 0, NE * (EROWS / 256) * 4); })
PHASE_FN(f_final, ph_final(p))

__global__ void __launch_bounds__(NTHREADS, 2) mega(P parg) {
    KP kp = (KP)__builtin_amdgcn_kernarg_segment_ptr();
    volatile LAS unsigned* xbw = (volatile LAS unsigned*)shm;
    if (threadIdx.x == 0) { xbw[0] = 0u; xbw[1] = 0u; xbw[2] = 0u; xbw[3] = 0u; }
    __syncthreads();
    XcdBarrier bar = xcd_barrier_post((unsigned*)(parg.ws + WS_BAR), xbw);
    int ph = 0; const int lo = parg.ph_lo, hi = parg.ph_hi;
#ifndef PROBE_XBAR
#define PROBE_XBAR 0
#endif
#define PH(fn, l) do { if (ph >= lo && ph < hi) { if (ph > lo) { xcd_barrier(bar); if (PROBE_XBAR) xcd_barrier(bar); } fn(kp, l); } ++ph; } while (0)
    PH(f_prologue, 0);
#pragma unroll 1
    for (int l = 0; l < DEPTH; ++l) {
        const int kind = l % 3;
        PH(f_norm1, l);
        if (kind == 0) { PH(f_qkv_gemm, l); PH(f_attn_a, l); PH(f_wo, l); }
        else if (kind == 1) { PH(f_qkv_gemm, l); PH(f_attn_b, l); PH(f_wo, l); }
        else { PH(f_mix, l); PH(f_g1, l); PH(f_g2, l); PH(f_scan, l); PH(f_readout, l); PH(f_wo, l); }
        PH(f_norm2, l); PH(f_select, l); PH(f_ffn1, l); PH(f_ffn2, l);
    }
    PH(f_final, DEPTH);
#undef PH
}

#ifndef MK_DEBUG
#define MK_DEBUG 0
#endif
constexpr size_t WS_DBG = 32768;
__global__ void dbg_chk(const void* ptr, size_t n, int type, unsigned* dbg, unsigned code) {
    unsigned bad = 0;
    for (size_t i = (size_t)blockIdx.x * blockDim.x + threadIdx.x; i < n; i += (size_t)gridDim.x * blockDim.x) {
        if (type == 0) { const float v = ((const float*)ptr)[i]; if (!(fabsf(v) < 1e6f)) bad = 1; }
        else if (type == 1) { const float v = bf2f(((const bf16_t*)ptr)[i]); if (!(fabsf(v) < 1e6f)) bad = 1; }
        else { const int v = ((const int*)ptr)[i]; if (v < 0 || v >= R) bad = 1; }
    }
    if (bad) atomicMax(dbg, 1000u - code);
}
__global__ void dbg_final(float* out, size_t n, unsigned* dbg) {
    __shared__ unsigned anybad;
    if (threadIdx.x == 0) anybad = 0; __syncthreads();
    unsigned bad = 0;
    for (size_t i = (size_t)blockIdx.x * blockDim.x + threadIdx.x; i < n; i += (size_t)gridDim.x * blockDim.x) { const float v = out[i]; if (!(fabsf(v) < 1e6f)) bad = 1; }
    if (bad) atomicMax(dbg + 64, 1u);
}
__global__ void dbg_write(float* out, size_t n, const unsigned* dbg) {
    const unsigned d = dbg[0], f = dbg[64]; if (d == 0 && f == 0) return;
    const float code = d ? (float)(1000u - d) * 100.f : 9900.f;
    for (size_t i = (size_t)blockIdx.x * blockDim.x + threadIdx.x; i < n; i += (size_t)gridDim.x * blockDim.x) out[i] = code;
}

constexpr int N_PHASES = 1 + 3 * 8 + 11 + 1;

extern "C" void kernel_launch(void* const* d_in, const int* in_sizes, int n_in, void* d_out, int out_size, void* d_ws, size_t ws_size, hipStream_t stream) {
    static int grid = 0;
    if (grid == 0) {
        if (n_in != 34 || in_sizes[0] != RL * D || out_size != RL * D || ws_size < WS_END) { fprintf(stderr, "kernel_launch: unexpected shapes: n_in %d in0 %d out %d ws %zu (need %zu)\n", n_in, n_in > 0 ? in_sizes[0] : -1, out_size, ws_size, (size_t)WS_END); grid = -1; return; }
        int dev = 0, cus = 0, per_cu = 0;
        if (hipGetDevice(&dev) != hipSuccess || hipDeviceGetAttribute(&cus, hipDeviceAttributeMultiprocessorCount, dev) != hipSuccess) { grid = -1; return; }
        if (hipFuncSetAttribute((const void*)mega, hipFuncAttributeMaxDynamicSharedMemorySize, LDS_BYTES) != hipSuccess) { fprintf(stderr, "kernel_launch: hipFuncSetAttribute failed\n"); grid = -1; return; }
        if (hipOccupancyMaxActiveBlocksPerMultiprocessor(&per_cu, (const void*)mega, NTHREADS, LDS_BYTES) != hipSuccess || per_cu < 1) fprintf(stderr, "kernel_launch: occupancy query says %d\n", per_cu);
        (void)hipGetLastError();
        grid = cus;
    }
    if (grid < 0) return;
    (void)hipMemsetAsync((char*)d_ws + WS_BAR, 0, 65536, stream);
    P p{};
    const float** pf = (const float**)&p;
    for (int i = 0; i < 34; ++i) pf[i] = (const float*)d_in[i];
    p.out = (float*)d_out; p.ws = (unsigned char*)d_ws;
#if MK_PER_PHASE
    for (int ph = 0; ph < N_PHASES; ++ph) { p.ph_lo = ph; p.ph_hi = ph + 1; hipLaunchKernelGGL(mega, dim3(grid), dim3(NTHREADS), LDS_BYTES, stream, p);
#if MK_DEBUG
        unsigned char* w = (unsigned char*)d_ws; unsigned* dbg = (unsigned*)(w + WS_DBG); const size_t RD = (size_t)R * D;
        auto CH = [&](size_t off, size_t n, int type) { hipLaunchKernelGGL(dbg_chk, dim3(1024), dim3(256), 0, stream, (const void*)(w + off), n, type, dbg, (unsigned)(ph + 1)); };
        int l = -1, loc = -1, kind = -1; { int q = ph - 1; if (ph == 0) loc = -1; else if (ph == N_PHASES - 1) loc = -2; else { for (l = 0; l < DEPTH; ++l) { const int np = (l % 3 == 2) ? 11 : 9; if (q < np) { loc = q; break; } q -= np; } kind = l % 3; } }
        if (ph == 0) { CH(WS_MODV, (size_t)DEPTH * 9 * 6144, 0); CH(WS_ROPE, 6144, 0); CH(WS_WQKV, (size_t)3 * 1536 * 1024, 1); CH(WS_WO, (size_t)4 * 1024 * 1024, 1); CH(WS_WRKV, (size_t)3 * 1024 * 1024, 1); CH(WS_WL1, (size_t)3 * 128 * 1024, 1); CH(WS_WL2, (size_t)(4 * 1024 * 64 + 1024 * 128), 1); }
        else if (loc >= 0) {
            const int nm = kind == 2 ? 6 : 4;
            if (loc == 0) { CH(WS_X, RD, 1); if (kind == 2) CH(WS_OFB, RD, 0); else CH(WS_H, RD, 1); CH(WS_F1, (size_t)NE * 4096 * 1024, 1); CH(WS_F2, (size_t)NE * 1024 * 2048, 1); }
            else if (loc <= nm) {
                if (kind != 2) { if (loc == 1) CH(WS_QKV, (size_t)R * 1536, 0); if (loc == 2) { CH(WS_QB, RD, 1); CH(WS_KB, (size_t)NB * KVLEN * 256, 1); CH(WS_VT, (size_t)NB * KVLEN * 256, 1); } if (loc == 3) CH(WS_O, RD, 1); if (loc == 4) CH(WS_X, RD, 1); }
                else { if (loc == 1) CH(WS_U1, 6 * RD, 1); if (loc == 2) { CH(WS_RKVB, 3 * RD, 1); CH(WS_L1, (size_t)3 * R * 128, 1); } if (loc == 3) { CH(WS_U1, 4 * RD, 0); CH(WS_GB, RD, 1); } if (loc == 4) CH(WS_OFB, 2 * RD, 0); if (loc == 5) CH(WS_O, RD, 1); if (loc == 6) CH(WS_X, RD, 1); }
            } else { const int m = loc - nm;
                if (m == 1) { CH(WS_H, RD, 1); CH(WS_AFF, (size_t)R * 16, 0); } if (m == 2) { CH(WS_GATE, PAIRS, 0); CH(WS_IDX, PAIRS, 2); } if (m == 3) CH(WS_HID, (size_t)PAIRS * FF, 1); if (m == 4) CH(WS_YEXP, (size_t)PAIRS * D, 1); }
        }
        if (ph == N_PHASES - 1) { hipLaunchKernelGGL(dbg_final, dim3(1024), dim3(256), 0, stream, (float*)d_out, (size_t)RL * D, dbg); hipLaunchKernelGGL(dbg_write, dim3(1024), dim3(256), 0, stream, (float*)d_out, (size_t)RL * D, (const unsigned*)dbg); }
#endif
    }
#else
    p.ph_lo = 0; p.ph_hi = N_PHASES; hipLaunchKernelGGL(mega, dim3(grid), dim3(NTHREADS), LDS_BYTES, stream, p);
#endif
    const hipError_t le = hipPeekAtLastError();
    if (le != hipSuccess) fprintf(stderr, "kernel_launch: launch failed: %s\n", hipGetErrorName(le));
}
```
